# Optimizing an MI355X kernel written in HIP

```python
import math
import jax, jax.numpy as jnp
from jax import lax
import numpy as np

D_MODEL = 2048
BATCH = 4
SEQ = 2048
DEPTH = 2

EPS = 1e-6
DSW_HEADS = 8
DSW_HEAD_DIM = D_MODEL // 16
DSW_WIDTH = DSW_HEADS * DSW_HEAD_DIM
DSW_PATTERNS = ((128, 1), (512, 4), (2048, 16))
DSW_BLOCK = 128
GLA_HEADS = 4
GLA_DK = D_MODEL // 16
GLA_DV = D_MODEL // 8
GLA_QK_WIDTH = GLA_HEADS * GLA_DK
GLA_WIDTH = GLA_HEADS * GLA_DV
GLA_RANK = 16
GLA_TAU = 16.0
S5_WIDTH = D_MODEL // 2
S5_GROUP = 16
S5_GROUPS = S5_WIDTH // S5_GROUP
S5_STATE = 64
S5_DT_MIN = 1e-3
S5_DT_MAX = 1e-1
HGRN_HEADS = 8
HGRN_DIM = D_MODEL // 16
HGRN_WIDTH = HGRN_HEADS * HGRN_DIM
CHUNK = 64
AB_WIDTH = DSW_WIDTH + GLA_WIDTH
CD_WIDTH = S5_WIDTH + HGRN_WIDTH
AB_SIZES = (DSW_WIDTH, DSW_WIDTH, DSW_WIDTH, GLA_QK_WIDTH, GLA_QK_WIDTH, GLA_WIDTH, GLA_RANK, AB_WIDTH)
CD_SIZES = (S5_WIDTH, HGRN_WIDTH, HGRN_WIDTH, HGRN_WIDTH, CD_WIDTH)
AB_IN = sum(AB_SIZES)
CD_IN = sum(CD_SIZES)
AB_SPLIT = tuple(int(v) for v in np.cumsum(AB_SIZES)[:-1])
CD_SPLIT = tuple(int(v) for v in np.cumsum(CD_SIZES)[:-1])
N_EVEN = (DEPTH + 1) // 2
N_ODD = DEPTH // 2

kernel_name = 'hybrid_dilated_gla_s5_hgrn2_trunk'


def rmsnorm(x, g):
    xf = x.astype(jnp.float32)
    return xf * lax.rsqrt(jnp.mean(xf * xf, axis=-1, keepdims=True) + EPS) * g


def head_rmsnorm(o, g):
    o = o * lax.rsqrt(jnp.mean(o * o, axis=-1, keepdims=True) + EPS)
    return o.reshape(o.shape[0], o.shape[1], -1) * g


def dilated_pattern(q, k, v, window, dilation):
    B, S, H, E = q.shape
    d = dilation
    M = S // d
    wc = window // d
    blk = DSW_BLOCK
    nb = -(-M // blk)
    Mp = nb * blk

    def strided(t):
        return jnp.pad(t.reshape(B, M, d, H, E), ((0, 0), (0, Mp - M), (0, 0), (0, 0), (0, 0)))

    def band(t):
        tp = jnp.pad(t, ((0, 0), (blk, 0), (0, 0), (0, 0), (0, 0)))
        prev = tp[:, :Mp].reshape(B, nb, blk, d, H, E)
        cur = t.reshape(B, nb, blk, d, H, E)
        return jnp.concatenate([prev, cur], axis=2)

    qb = strided(q).reshape(B, nb, blk, d, H, E)
    kb = band(strided(k))
    vb = band(strided(v))
    s = jnp.einsum('bnidhe,bnjdhe->bndhij', qb, kb) * (E ** -0.5)
    i_idx = np.arange(blk)[:, None]
    j_idx = np.arange(2 * blk)[None, :]
    n_idx = np.arange(nb)[:, None, None]
    offset = blk + i_idx - j_idx
    key_pos = (n_idx - 1) * blk + j_idx
    mask = (offset >= 0) & (offset <= wc) & (key_pos >= 0)
    s = jnp.where(mask[None, :, None, None], s, -jnp.inf)
    m = jnp.max(s, axis=-1, keepdims=True)
    p = jnp.exp(s - m)
    den = jnp.sum(p, axis=-1)
    o = jnp.einsum('bndhij,bnjdhe->bnidhe', p, vb) / jnp.transpose(den, (0, 1, 4, 2, 3))[..., None]
    lse = jnp.transpose(m[..., 0] + jnp.log(den), (0, 1, 4, 2, 3))
    o = o.reshape(B, Mp, d, H, E)[:, :M].reshape(B, S, H, E)
    lse = lse.reshape(B, Mp, d, H)[:, :M].reshape(B, S, H)
    return o, lse


def dilated_attention(q, k, v):
    outs, lses = [], []
    for window, dilation in DSW_PATTERNS:
        o, lse = dilated_pattern(q, k, v, window, dilation)
        outs.append(o)
        lses.append(lse)
    w = jax.nn.softmax(jnp.stack(lses, axis=0), axis=0)
    return jnp.einsum('pbsh,pbshe->bshe', w, jnp.stack(outs, axis=0))


def chunked_gated_linear_attention(q, k, v, log_g):
    B, S, H, K = q.shape
    V = v.shape[-1]
    n = S // CHUNK

    def blocks(t):
        return jnp.moveaxis(t.reshape(B, n, CHUNK, H, t.shape[-1]), 1, 0)

    qc, kc, vc = blocks(q), blocks(k), blocks(v)
    bc = jnp.cumsum(blocks(log_g), axis=2)
    causal = np.tril(np.ones((CHUNK, CHUNK), dtype=bool))[None, :, :, None, None]

    def step(state, inp):
        qi, ki, vi, bi = inp
        inter = jnp.einsum('bihk,bhkv->bihv', qi * jnp.exp(bi), state)
        diff = bi[:, :, None] - bi[:, None, :]
        decay = jnp.exp(jnp.where(causal, diff, -jnp.inf))
        scores = jnp.einsum('bihk,bjhk,bijhk->bhij', qi, ki, decay)
        intra = jnp.einsum('bhij,bjhv->bihv', scores, vi)
        b_last = bi[:, -1]
        k_dec = ki * jnp.exp(b_last[:, None] - bi)
        state = state * jnp.exp(b_last)[..., None] + jnp.einsum('bjhk,bjhv->bhkv', k_dec, vi)
        return state, inter + intra

    state0 = jnp.zeros((B, H, K, V), jnp.float32)
    _, out = lax.scan(step, state0, (qc, kc, vc, bc))
    return jnp.moveaxis(out, 0, 1).reshape(B, S, H, V)


def _cmul(ar, ai, br, bi):
    return ar * br - ai * bi, ar * bi + ai * br


def _s5_combine(e1, e2):
    a1r, a1i, b1r, b1i = e1
    a2r, a2i, b2r, b2i = e2
    ar, ai = _cmul(a2r, a2i, a1r, a1i)
    br, bi = _cmul(a2r, a2i, b1r, b1i)
    return ar, ai, br + b2r, bi + b2i


def s5_mixer(u, lam_re, lam_im, log_dt, b_re, b_im, c_re, c_im, d_skip, w_glu, b_glu):
    B, S, _ = u.shape
    f32 = jnp.float32
    lam_re, lam_im = lam_re.astype(f32), lam_im.astype(f32)
    b_re, b_im, c_re, c_im = b_re.astype(f32), b_im.astype(f32), c_re.astype(f32), c_im.astype(f32)
    ug = u.reshape(B, S, S5_GROUPS, S5_GROUP)
    dt = jnp.exp(log_dt.astype(f32))[:, None]
    mag = jnp.exp(lam_re * dt)
    ang = lam_im * dt
    ab_re, ab_im = mag * jnp.cos(ang), mag * jnp.sin(ang)
    inv = 1.0 / (lam_re * lam_re + lam_im * lam_im)
    nr, ni = ab_re - 1.0, ab_im
    co_re = (nr * lam_re + ni * lam_im) * inv
    co_im = (ni * lam_re - nr * lam_im) * inv
    bb_re, bb_im = _cmul(co_re[..., None], co_im[..., None], b_re, b_im)
    ut = jnp.swapaxes(ug, 0, 1)
    bu_re = jnp.einsum('gph,sbgh->sbgp', bb_re, ut)
    bu_im = jnp.einsum('gph,sbgh->sbgp', bb_im, ut)
    a_re = jnp.broadcast_to(ab_re, (S, 1, S5_GROUPS, S5_STATE))
    a_im = jnp.broadcast_to(ab_im, (S, 1, S5_GROUPS, S5_STATE))
    _, _, x_re, x_im = lax.associative_scan(_s5_combine, (a_re, a_im, bu_re, bu_im), axis=0)
    y = (jnp.einsum('ghp,sbgp->bsgh', c_re, x_re) - jnp.einsum('ghp,sbgp->bsgh', c_im, x_im)
         + d_skip * ug)
    y = jax.nn.gelu(y.reshape(B, S, S5_WIDTH))
    return y * jax.nn.sigmoid(y @ w_glu + b_glu)


def ab_layer(h, w_in, gla_w_gate, gla_b_gate, gla_norm_g, w_out):
    B, S, _ = h.shape
    z = h @ w_in
    qa, ka, va, qb, kb, vb, g_low, gate = jnp.split(z, AB_SPLIT, axis=-1)
    sh_a = (B, S, DSW_HEADS, DSW_HEAD_DIM)
    ya = dilated_attention(qa.reshape(sh_a), ka.reshape(sh_a), va.reshape(sh_a)).reshape(B, S, DSW_WIDTH)
    log_a = jax.nn.log_sigmoid(g_low @ gla_w_gate + gla_b_gate) / GLA_TAU
    sh_k = (B, S, GLA_HEADS, GLA_DK)
    ob = chunked_gated_linear_attention((qb * GLA_DK ** -0.5).reshape(sh_k), kb.reshape(sh_k),
                                        vb.reshape(B, S, GLA_HEADS, GLA_DV), log_a.reshape(sh_k))
    yb = head_rmsnorm(ob, gla_norm_g)
    y = jnp.concatenate([ya, yb], axis=-1) * jax.nn.silu(gate)
    return y @ w_out


def cd_layer(h, w_in, lam_re, lam_im, log_dt, b_re, b_im, c_re, c_im, d_skip, w_glu, b_glu,
             lower_bound, hgrn_norm_g, w_out):
    B, S, _ = h.shape
    z = h @ w_in
    u, qd, fd, idd, gate = jnp.split(z, CD_SPLIT, axis=-1)
    yc = s5_mixer(u, lam_re, lam_im, log_dt, b_re, b_im, c_re, c_im, d_skip, w_glu, b_glu)
    f = lower_bound + (1.0 - lower_bound) * jax.nn.sigmoid(fd)
    sh = (B, S, HGRN_HEADS, HGRN_DIM)
    od = chunked_gated_linear_attention(jax.nn.silu(qd).reshape(sh), (1.0 - f).reshape(sh),
                                        idd.reshape(sh), jnp.log(f).reshape(sh))
    yd = head_rmsnorm(od, hgrn_norm_g)
    y = jnp.concatenate([yc, yd], axis=-1) * jax.nn.silu(gate)
    return y @ w_out


def setup_inputs(seed: int = 0) -> dict:
    key = jax.random.key(seed)
    ks = jax.random.split(key, 24)
    f32 = jnp.float32

    def nrm(k, shape, s):
        return s * jax.random.normal(k, shape, f32)

    G, P, Hc = S5_GROUPS, S5_STATE, S5_GROUP
    return {
        'x': nrm(ks[0], (BATCH, SEQ, D_MODEL), 1.0),
        'norm_g': 1.0 + nrm(ks[1], (DEPTH, D_MODEL), 0.02),
        'final_g': 1.0 + nrm(ks[2], (D_MODEL,), 0.02),
        'ab_w_in': nrm(ks[3], (N_EVEN, D_MODEL, AB_IN), D_MODEL ** -0.5),
        'gla_w_gate': nrm(ks[4], (N_EVEN, GLA_RANK, GLA_QK_WIDTH), GLA_RANK ** -0.5),
        'gla_b_gate': nrm(ks[5], (N_EVEN, GLA_QK_WIDTH), 0.1),
        'gla_norm_g': 1.0 + nrm(ks[6], (N_EVEN, GLA_WIDTH), 0.02),
        'ab_w_out': nrm(ks[7], (N_EVEN, AB_WIDTH, D_MODEL), AB_WIDTH ** -0.5),
        'cd_w_in': nrm(ks[8], (N_ODD, D_MODEL, CD_IN), D_MODEL ** -0.5),
        's5_lam_re': -0.5 + nrm(ks[9], (N_ODD, G, P), 0.01),
        's5_lam_im': math.pi * jnp.arange(P, dtype=f32) + nrm(ks[10], (N_ODD, G, P), 0.01),
        's5_log_dt': jax.random.uniform(ks[11], (N_ODD, G), f32, math.log(S5_DT_MIN), math.log(S5_DT_MAX)),
        's5_b_re': nrm(ks[12], (N_ODD, G, P, Hc), (2 * Hc) ** -0.5),
        's5_b_im': nrm(ks[13], (N_ODD, G, P, Hc), (2 * Hc) ** -0.5),
        's5_c_re': nrm(ks[14], (N_ODD, G, Hc, P), 0.5),
        's5_c_im': nrm(ks[15], (N_ODD, G, Hc, P), 0.5),
        's5_d': nrm(ks[16], (N_ODD, G, Hc), 1.0),
        's5_w_glu': nrm(ks[17], (N_ODD, S5_WIDTH, S5_WIDTH), S5_WIDTH ** -0.5),
        's5_b_glu': nrm(ks[18], (N_ODD, S5_WIDTH), 0.1),
        'hgrn_gamma': nrm(ks[19], (DEPTH, HGRN_WIDTH), 1.0),
        'hgrn_norm_g': 1.0 + nrm(ks[20], (N_ODD, HGRN_WIDTH), 0.02),
        'cd_w_out': nrm(ks[21], (N_ODD, CD_WIDTH, D_MODEL), CD_WIDTH ** -0.5),
    }


def reference(x, norm_g, final_g, ab_w_in, gla_w_gate, gla_b_gate, gla_norm_g, ab_w_out,
              cd_w_in, s5_lam_re, s5_lam_im, s5_log_dt, s5_b_re, s5_b_im, s5_c_re, s5_c_im,
              s5_d, s5_w_glu, s5_b_glu, hgrn_gamma, hgrn_norm_g, cd_w_out):
    h = x.astype(jnp.float32)
    sm = jax.nn.softmax(hgrn_gamma.astype(jnp.float32), axis=0)
    lower_bounds = jnp.cumsum(sm, axis=0) - sm[0]
    for l in range(DEPTH):
        hn = rmsnorm(h, norm_g[l])
        j = l // 2
        if l % 2 == 0:
            h = h + ab_layer(hn, ab_w_in[j], gla_w_gate[j], gla_b_gate[j], gla_norm_g[j], ab_w_out[j])
        else:
            h = h + cd_layer(hn, cd_w_in[j], s5_lam_re[j], s5_lam_im[j], s5_log_dt[j], s5_b_re[j],
                             s5_b_im[j], s5_c_re[j], s5_c_im[j], s5_d[j], s5_w_glu[j], s5_b_glu[j],
                             lower_bounds[l], hgrn_norm_g[j], cd_w_out[j])
    return rmsnorm(h, final_g).astype(x.dtype)
```

```cpp
#include <hip/hip_runtime.h>
#include <hip/hip_cooperative_groups.h>
#include <cstdio>
#include <cstdint>
namespace cg = cooperative_groups;

#ifndef DBG_REP
#define DBG_REP 0
#endif
#ifndef N_LAUNCH_MODE
#define N_LAUNCH_MODE 1
#endif

typedef unsigned short bf16_t;
typedef short bf16x8 __attribute__((ext_vector_type(8)));
typedef short s16x4 __attribute__((ext_vector_type(4)));
typedef float f32x4 __attribute__((ext_vector_type(4)));
typedef float f32x2 __attribute__((ext_vector_type(2)));
typedef unsigned u32x4 __attribute__((ext_vector_type(4)));
typedef unsigned u32x2 __attribute__((ext_vector_type(2)));
#define LAS __attribute__((address_space(3)))

constexpr int NTOK = 8192, DM = 2048, SEQ = 2048;
constexpr int LDZ0 = 7424, LDZ1 = 5120;
constexpr int LDS_BYTES = 155648 + 16;
constexpr int NPHASE = 15;

constexpr size_t WS_WT_IN0 = 0;
constexpr size_t WS_WT_OUT0 = 30408704;
constexpr size_t WS_WT_IN1 = 38797312;
constexpr size_t WS_WT_GLU = 63963136;
constexpr size_t WS_WT_OUT1 = 66060288;
constexpr size_t WS_HN = 74448896;
constexpr size_t WS_Z = 108003328;
constexpr size_t WS_OB = 229638144;
constexpr size_t WS_YC = 246415360;
constexpr size_t WS_END = 263192576;
constexpr size_t WS_S5B1 = 0;
constexpr size_t WS_S5B2 = 8388608;
constexpr size_t WS_XLOC = 20971520;
constexpr size_t WS_S5A = WS_Z + 83886080;
constexpr size_t DO_LSE = 50331648;

struct Params {
    const float* x; const float* norm_g; const float* final_g; const float* ab_w_in; const float* gla_w_gate; const float* gla_b_gate;
    const float* gla_norm_g; const float* ab_w_out; const float* cd_w_in; const float* lam_re; const float* lam_im; const float* log_dt;
    const float* b_re; const float* b_im; const float* c_re; const float* c_im; const float* s5_d; const float* w_glu; const float* b_glu;
    const float* hgrn_gamma; const float* hgrn_norm_g; const float* cd_w_out;
    float* out; unsigned char* ws;
    int ph_lo, ph_hi;
};

__device__ __forceinline__ int otid() { int t = threadIdx.x; asm volatile("" : "+v"(t)); return t; }
__device__ __forceinline__ float bf2f(bf16_t b) { return __uint_as_float(((unsigned)b) << 16); }
typedef __bf16 bf16v2_t __attribute__((ext_vector_type(2)));
__device__ __forceinline__ unsigned cvt_pk_bf16(float lo, float hi) { bf16v2_t v = {(__bf16)lo, (__bf16)hi}; return __builtin_bit_cast(unsigned, v); }
__device__ __forceinline__ bf16_t f2bf(float f) { return (bf16_t)(cvt_pk_bf16(f, 0.f) & 0xffffu); }
__device__ __forceinline__ float lo_bf(unsigned w) { return __uint_as_float(w << 16); }
__device__ __forceinline__ float hi_bf(unsigned w) { return __uint_as_float(w & 0xffff0000u); }
__device__ __forceinline__ float sigmoidf_(float x) { return __builtin_amdgcn_rcpf(1.0f + __expf(-x)); }
__device__ __forceinline__ float siluf_(float x) { return x * sigmoidf_(x); }
__device__ __forceinline__ float logsigmoidf_(float x) { return fminf(x, 0.f) - __logf(1.0f + __expf(-fabsf(x))); }
typedef __bf16 bf16p2_t __attribute__((ext_vector_type(2)));
__device__ __forceinline__ float dot2bf(unsigned a, unsigned b, float c) { return __builtin_amdgcn_fdot2_f32_bf16(__builtin_bit_cast(bf16p2_t, a), __builtin_bit_cast(bf16p2_t, b), c, false); }
__device__ __forceinline__ f32x4 mfma16(bf16x8 a, bf16x8 b, f32x4 c) { return __builtin_amdgcn_mfma_f32_16x16x32_bf16(a, b, c, 0, 0, 0); }
__device__ __forceinline__ u32x2 pack4(f32x4 v) { u32x2 w; w.x = cvt_pk_bf16(v[0], v[1]); w.y = cvt_pk_bf16(v[2], v[3]); return w; }

__device__ __forceinline__ int map_col(int mode, int n, int nsrc) {
    if (mode == 1) { if (n < 5120) return n; if (n < 7168) return n + 16; if (n < 7184) return n - 2048; return -1; }
    return n < nsrc ? n : -1;
}
__device__ __forceinline__ void convert_wt(const float* __restrict__ W, int K, int Nsrc, bf16_t* __restrict__ WT, int Ndst, int mode, float* tile, int bid, int nb) {
    const int tid = otid(); const int tk = K / 64, tn = Ndst / 256, total = tk * tn;
    const int nn = tid & 63, kk = tid >> 6, n2 = tid >> 3, kq = tid & 7;
    float v[4][8];
#define CW_ISSUE(it_) do { const int n0_ = ((it_) / tk) * 256, k0_ = ((it_) % tk) * 64; _Pragma("unroll") for (int q = 0; q < 4; ++q) { const int sc = map_col(mode, n0_ + q * 64 + nn, Nsrc); \
        _Pragma("unroll") for (int i = 0; i < 8; ++i) v[q][i] = sc >= 0 ? __builtin_nontemporal_load(W + (size_t)(k0_ + kk * 8 + i) * Nsrc + sc) : 0.f; } } while (0)
    int it = bid; if (it < total) CW_ISSUE(it);
    for (; it < total; it += nb) {
        const int n0 = (it / tk) * 256, k0 = (it % tk) * 64;
#pragma unroll
        for (int q = 0; q < 4; ++q)
#pragma unroll
            for (int i = 0; i < 8; ++i) tile[q * 4160 + (kk * 8 + i) * 65 + nn] = v[q][i];
        if (it + nb < total) CW_ISSUE(it + nb);
        __syncthreads();
#pragma unroll
        for (int q = 0; q < 4; ++q) { float r[8];
#pragma unroll
            for (int j = 0; j < 8; ++j) r[j] = tile[q * 4160 + (kq * 8 + j) * 65 + n2];
            u32x4 w; w.x = cvt_pk_bf16(r[0], r[1]); w.y = cvt_pk_bf16(r[2], r[3]); w.z = cvt_pk_bf16(r[4], r[5]); w.w = cvt_pk_bf16(r[6], r[7]);
            *(u32x4*)(WT + (size_t)(n0 + q * 64 + n2) * K + k0 + kq * 8) = w; }
        __syncthreads();
    }
#undef CW_ISSUE
}
template <bool OUT_BF16, int RPT = 2>
__device__ __forceinline__ void rmsnorm_rows(const float* X, const float* __restrict__ g, void* outp, int bid, int nb) {
    const int tid_ = otid(); const int wid = tid_ >> 6, lane = tid_ & 63;
    const int step = nb * 8;
    for (int row = bid * 8 + wid; row < NTOK; row += RPT * step) {
        f32x4 v[RPT][8]; float ss[RPT]; int rr[RPT]; bool has[RPT];
#pragma unroll
        for (int r = 0; r < RPT; ++r) { rr[r] = row + r * step; has[r] = rr[r] < NTOK; if (!has[r]) rr[r] = row; }
#pragma unroll
        for (int r = 0; r < RPT; ++r)
#pragma unroll
            for (int i = 0; i < 8; ++i) v[r][i] = *(const f32x4*)(X + (size_t)rr[r] * DM + (i * 64 + lane) * 4);
#pragma unroll
        for (int r = 0; r < RPT; ++r) { float s = 0.f;
#pragma unroll
            for (int i = 0; i < 8; ++i) s += v[r][i][0] * v[r][i][0] + v[r][i][1] * v[r][i][1] + v[r][i][2] * v[r][i][2] + v[r][i][3] * v[r][i][3];
#pragma unroll
            for (int o = 32; o >= 1; o >>= 1) s += __shfl_xor(s, o);
            ss[r] = rsqrtf(s * (1.0f / DM) + 1e-6f); }
#pragma unroll
        for (int i = 0; i < 8; ++i) { const f32x4 gg = *(const f32x4*)(g + (i * 64 + lane) * 4);
#pragma unroll
            for (int r = 0; r < RPT; ++r) if (has[r]) {
                if (OUT_BF16) *(u32x2*)((bf16_t*)outp + (size_t)rr[r] * DM + (i * 64 + lane) * 4) = pack4(v[r][i] * ss[r] * gg);
                else *(f32x4*)((float*)outp + (size_t)rr[r] * DM + (i * 64 + lane) * 4) = v[r][i] * ss[r] * gg; } }
    }
}

namespace pg8 {
constexpr int BM = 256, BK = 64, HALF = 128, HTB = HALF * BK * 2, STAGE_BYTES = 8 * HTB, NXCD = 8, WGM = 4;
__device__ __forceinline__ int lds_byte(int r, int c) { const int st = (r >> 4) * 2 + (c >> 5), rr = r & 15, cc = c & 31, ob = rr * 64 + cc * 2; return st * 1024 + (ob ^ (((ob >> 9) & 1) << 5)); }
__device__ __forceinline__ void stage_rc(int b, int& R, int& C) { const int st = b / 1024, sb = b % 1024, swz = sb ^ (((sb >> 9) & 1) << 5); R = (st >> 1) * 16 + swz / 64; C = (st & 1) * 32 + (swz % 64) / 2; }
__device__ __forceinline__ int perm32(int rho) { const int n = rho >> 4, i = rho & 15; return 8 * (i >> 2) + 4 * n + (i & 3); }
struct Unit { int pm, pn; };
struct Gemm { const bf16_t* A; const bf16_t* Bt; int lda, ldb, K; };
struct StaticOrder {
    int nM, nN, nwg, G, c;
    __device__ void init(int M, int N, int G_, int c_) { nM = M / BM; nN = N / BM; nwg = nM * nN; G = G_; c = c_; }
    __device__ bool next(int i, Unit& u) const {
        const long L = (long)i * G + c; if (c < 0 || L >= nwg) return false;
        int wgid = (int)L; { const int q = nwg / NXCD, r = nwg % NXCD, xcd = wgid % NXCD, off = wgid / NXCD; wgid = (xcd < r ? xcd * (q + 1) : r * (q + 1) + (xcd - r) * q) + off; }
        const int nig = WGM * nN, gid = wgid / nig, fm = gid * WGM, gsz = (nM - fm) < WGM ? (nM - fm) : WGM;
        u.pm = fm + ((wgid % nig) % gsz); u.pn = (wgid % nig) / gsz; return true;
    }
};
struct DiagOrder {
    int n, G, c;
    __device__ bool next(int i, Unit& u) const { const int L = i * G + c; if (c < 0 || L >= n) return false; u.pm = L; u.pn = L >> 1; return true; }
};

struct EpiZ0 {
    static constexpr bool PERM = true, AFTER_DRAIN = false, ACC_INIT = false;
    bf16_t* O;
    __device__ __forceinline__ void operator()(const f32x4 (&acc)[2][2][4][2], const Unit& u, int wr, int wc, int fr, int fq) const {
        const int row0 = u.pm * BM + wr * 64 + fr, col0 = u.pn * BM + wc * 32 + 8 * fq;
#pragma unroll
        for (int ai = 0; ai < 2; ++ai)
#pragma unroll
            for (int m = 0; m < 4; ++m) { bf16_t* rowp = O + (size_t)(row0 + ai * HALF + m * 16) * LDZ0 + col0;
#pragma unroll
                for (int bj = 0; bj < 2; ++bj) { const f32x4 v0 = acc[ai][bj][m][0], v1 = acc[ai][bj][m][1];
                    u32x4 w; w.x = cvt_pk_bf16(v0[0], v0[1]); w.y = cvt_pk_bf16(v0[2], v0[3]); w.z = cvt_pk_bf16(v1[0], v1[1]); w.w = cvt_pk_bf16(v1[2], v1[3]);
                    *(u32x4*)(rowp + bj * HALF) = w; } }
    }
};
struct EpiZ1 {
    static constexpr bool PERM = true, AFTER_DRAIN = false, ACC_INIT = false;
    bf16_t* Z1; bf16_t* S5A;
    __device__ __forceinline__ void operator()(const f32x4 (&acc)[2][2][4][2], const Unit& u, int wr, int wc, int fr, int fq) const {
        const int row0 = u.pm * BM + wr * 64 + fr, col0 = u.pn * BM + wc * 32 + 8 * fq;
#pragma unroll
        for (int ai = 0; ai < 2; ++ai)
#pragma unroll
            for (int m = 0; m < 4; ++m) { const int t = row0 + ai * HALF + m * 16;
#pragma unroll
                for (int bj = 0; bj < 2; ++bj) { const f32x4 v0 = acc[ai][bj][m][0], v1 = acc[ai][bj][m][1];
                    u32x4 w; w.x = cvt_pk_bf16(v0[0], v0[1]); w.y = cvt_pk_bf16(v0[2], v0[3]); w.z = cvt_pk_bf16(v1[0], v1[1]); w.w = cvt_pk_bf16(v1[2], v1[3]);
                    const int c = col0 + bj * HALF;
                    if (u.pn < 4) *(u32x4*)(S5A + ((size_t)((c >> 4) * 512 + (t >> 4))) * 384 + (t & 15) * 16 + (c & 15)) = w;
                    else *(u32x4*)(Z1 + (size_t)t * LDZ1 + (c - 1024)) = w; } }
    }
};
struct EpiRes {
    static constexpr bool PERM = false, AFTER_DRAIN = false, ACC_INIT = false;
    const float* base; float* out;
    __device__ __forceinline__ void operator()(const f32x4 (&acc)[2][2][4][2], const Unit& u, int wr, int wc, int fr, int fq) const {
        const int row0 = u.pm * BM + wr * 64 + fr, col0 = u.pn * BM + wc * 32 + 4 * fq;
#pragma unroll
        for (int ai = 0; ai < 2; ++ai)
#pragma unroll
            for (int m = 0; m < 4; ++m) { const size_t off = (size_t)(row0 + ai * HALF + m * 16) * DM + col0;
#pragma unroll
                for (int bj = 0; bj < 2; ++bj)
#pragma unroll
                    for (int n = 0; n < 2; ++n) { const f32x4 bs = *(const f32x4*)(base + off + bj * HALF + n * 16); *(f32x4*)(out + off + bj * HALF + n * 16) = bs + acc[ai][bj][m][n]; } }
    }
};
struct EpiXloc {
    static constexpr bool PERM = false, AFTER_DRAIN = false, ACC_INIT = false;
    float* X;
    __device__ __forceinline__ void operator()(const f32x4 (&acc)[2][2][4][2], const Unit& u, int wr, int wc, int fr, int fq) const {
        const int row0 = u.pm * BM + wr * 64 + fr, col0 = wc * 32 + 4 * fq;
#pragma unroll
        for (int ai = 0; ai < 2; ++ai)
#pragma unroll
            for (int m = 0; m < 4; ++m) { float* rowp = X + (size_t)(row0 + ai * HALF + m * 16) * 128 + col0;
#pragma unroll
                for (int n = 0; n < 2; ++n) *(f32x4*)(rowp + n * 16) = acc[ai][0][m][n]; }
    }
};
__device__ __forceinline__ float gelu_tanh(float y) { const float z = 1.5957691216057308f * (y + 0.044715f * y * y * y); return y / (1.0f + __expf(-z)); }
struct EpiS2 {
    static constexpr bool PERM = true, AFTER_DRAIN = false, ACC_INIT = false;
    bf16_t* YC;
    __device__ __forceinline__ void operator()(const f32x4 (&acc)[2][2][4][2], const Unit& u, int wr, int wc, int fr, int fq) const {
        const int row0 = u.pm * BM + wr * 64 + fr, col0 = wc * 32 + 8 * fq;
#pragma unroll
        for (int ai = 0; ai < 2; ++ai)
#pragma unroll
            for (int m = 0; m < 4; ++m) { const int R = row0 + ai * HALF + m * 16, g = R >> 9, ch = R & 511;
#pragma unroll
                for (int bj = 0; bj < 2; ++bj) { const f32x4 v0 = acc[ai][bj][m][0], v1 = acc[ai][bj][m][1];
                    u32x4 w; w.x = cvt_pk_bf16(gelu_tanh(v0[0]), gelu_tanh(v0[1])); w.y = cvt_pk_bf16(gelu_tanh(v0[2]), gelu_tanh(v0[3]));
                    w.z = cvt_pk_bf16(gelu_tanh(v1[0]), gelu_tanh(v1[1])); w.w = cvt_pk_bf16(gelu_tanh(v1[2]), gelu_tanh(v1[3]));
                    const int c = col0 + bj * HALF;
                    *(u32x4*)(YC + (size_t)(ch * 16 + (c >> 4)) * 1024 + g * 16 + (c & 15)) = w; } asm volatile("" ::: "memory"); }
    }
};
struct EpiGlu {
    static constexpr bool PERM = true, AFTER_DRAIN = false, ACC_INIT = false;
    const bf16_t* YC; const bf16_t* Z1; const float* bglu; bf16_t* Y;
    __device__ __forceinline__ void operator()(const f32x4 (&acc)[2][2][4][2], const Unit& u, int wr, int wc, int fr, int fq) const {
        const int row0 = u.pm * BM + wr * 64 + fr, col0 = u.pn * BM + wc * 32 + 8 * fq;
#pragma unroll
        for (int ai = 0; ai < 2; ++ai)
#pragma unroll
            for (int m = 0; m < 4; ++m) { const int t = row0 + ai * HALF + m * 16;
#pragma unroll
                for (int bj = 0; bj < 2; ++bj) { const int c = col0 + bj * HALF;
                    const u32x4 yv = *(const u32x4*)(YC + (size_t)t * 1024 + c); const u32x4 gv = *(const u32x4*)(Z1 + (size_t)t * LDZ1 + 3072 + c);
                    const f32x4 b0 = *(const f32x4*)(bglu + c), b1 = *(const f32x4*)(bglu + c + 4);
                    const f32x4 v0 = acc[ai][bj][m][0] + b0, v1 = acc[ai][bj][m][1] + b1;
                    float r[8];
                    r[0] = lo_bf(yv.x) * sigmoidf_(v0[0]) * siluf_(lo_bf(gv.x)); r[1] = hi_bf(yv.x) * sigmoidf_(v0[1]) * siluf_(hi_bf(gv.x));
                    r[2] = lo_bf(yv.y) * sigmoidf_(v0[2]) * siluf_(lo_bf(gv.y)); r[3] = hi_bf(yv.y) * sigmoidf_(v0[3]) * siluf_(hi_bf(gv.y));
                    r[4] = lo_bf(yv.z) * sigmoidf_(v1[0]) * siluf_(lo_bf(gv.z)); r[5] = hi_bf(yv.z) * sigmoidf_(v1[1]) * siluf_(hi_bf(gv.z));
                    r[6] = lo_bf(yv.w) * sigmoidf_(v1[2]) * siluf_(lo_bf(gv.w)); r[7] = hi_bf(yv.w) * sigmoidf_(v1[3]) * siluf_(hi_bf(gv.w));
                    u32x4 w; w.x = cvt_pk_bf16(r[0], r[1]); w.y = cvt_pk_bf16(r[2], r[3]); w.z = cvt_pk_bf16(r[4], r[5]); w.w = cvt_pk_bf16(r[6], r[7]);
                    *(u32x4*)(Y + (size_t)t * DM + c) = w; } }
    }
};

template <bool FINAL> struct EpiNorm {
    static constexpr bool PERM = false, AFTER_DRAIN = true, ACC_INIT = true;
    const float* base; float* hout; bf16_t* nout; const float* g; float* xs; unsigned* cnt;
    __device__ __forceinline__ void init(f32x4 (&acc)[2][2][4][2], const Unit& u, int wr, int wc, int fr, int fq) const {
        const int row0 = u.pm * BM + wr * 64 + fr, col0 = u.pn * BM + wc * 32 + 4 * fq;
#pragma unroll
        for (int ai = 0; ai < 2; ++ai)
#pragma unroll
            for (int m = 0; m < 4; ++m) { const size_t off = (size_t)(row0 + ai * HALF + m * 16) * DM + col0;
#pragma unroll
                for (int bj = 0; bj < 2; ++bj)
#pragma unroll
                    for (int n = 0; n < 2; ++n) acc[ai][bj][m][n] = *(const f32x4*)(base + off + bj * HALF + n * 16); }
    }
    __device__ __forceinline__ void operator()(const f32x4 (&)[2][2][4][2], const Unit&, int, int, int, int) const {}
    __device__ __forceinline__ void fused(f32x4 (&acc)[2][2][4][2], const Unit& u, int wr, int wc, int fr, int fq, LAS unsigned char* lds, int wid, int lane) const {
        LAS float* PT = (LAS float*)lds;
        LAS float* ST = (LAS float*)(lds + 4096);
        const int row0 = u.pm * BM + wr * 64 + fr, col0 = u.pn * BM + wc * 32 + 4 * fq;
#pragma unroll
        for (int ai = 0; ai < 2; ++ai)
#pragma unroll
            for (int m = 0; m < 4; ++m) { const size_t off = (size_t)(row0 + ai * HALF + m * 16) * DM + col0; float s = 0.f;
#pragma unroll
                for (int bj = 0; bj < 2; ++bj)
#pragma unroll
                    for (int n = 0; n < 2; ++n) { const f32x4 h = acc[ai][bj][m][n];
                        s += h[0] * h[0] + h[1] * h[1] + h[2] * h[2] + h[3] * h[3]; }
                s += __shfl_xor(s, 16); s += __shfl_xor(s, 32);
                if (fq == 0) PT[(ai * HALF + wr * 64 + m * 16 + fr) * 4 + wc] = s; }
        __syncthreads();
        const int row = wid * 32 + (lane & 31);
        if (lane < 32) { const float tot = (PT[row * 4] + PT[row * 4 + 1]) + (PT[row * 4 + 2] + PT[row * 4 + 3]);
            __hip_atomic_store(xs + ((size_t)(u.pm * BM + row)) * 8 + u.pn, tot, __ATOMIC_RELAXED, __HIP_MEMORY_SCOPE_AGENT); }
        asm volatile("s_waitcnt vmcnt(0)" ::: "memory");
        if (lane == 0) __hip_atomic_fetch_add(cnt + 64 * u.pm, 1u, __ATOMIC_RELAXED, __HIP_MEMORY_SCOPE_AGENT);
        if (wid == 0) { unsigned sp = 0;
            while ((unsigned)__builtin_amdgcn_readfirstlane(__hip_atomic_load(cnt + 64 * u.pm, __ATOMIC_RELAXED, __HIP_MEMORY_SCOPE_AGENT)) < 64u) { __builtin_amdgcn_s_sleep(2); if (++sp > (1u << 22)) break; }
            __builtin_amdgcn_fence(__ATOMIC_ACQUIRE, "agent");
            asm volatile("s_waitcnt vmcnt(0)" ::: "memory"); }
        __syncthreads();
        if (lane < 32) { const float* sl = xs + ((size_t)(u.pm * BM + row)) * 8; float tot = 0.f;
#pragma unroll
            for (int t = 0; t < 8; ++t) tot += __hip_atomic_load(sl + t, __ATOMIC_RELAXED, __HIP_MEMORY_SCOPE_AGENT);
            ST[row] = rsqrtf(tot * (1.0f / DM) + 1e-6f); }
        __syncthreads();
        f32x4 ggv[2][2];
#pragma unroll
        for (int bj = 0; bj < 2; ++bj)
#pragma unroll
            for (int n = 0; n < 2; ++n) ggv[bj][n] = *(const f32x4*)(g + col0 + bj * HALF + n * 16);
#pragma unroll
        for (int ai = 0; ai < 2; ++ai)
#pragma unroll
            for (int m = 0; m < 4; ++m) { const int r = ai * HALF + wr * 64 + m * 16 + fr; const float rinv = ST[r]; const size_t off = (size_t)(u.pm * BM + r) * DM + col0;
#pragma unroll
                for (int bj = 0; bj < 2; ++bj)
#pragma unroll
                    for (int n = 0; n < 2; ++n) { const f32x4 gg = ggv[bj][n]; const f32x4 h = acc[ai][bj][m][n];
                        if (FINAL) *(f32x4*)(hout + off + bj * HALF + n * 16) = h * rinv * gg;
                        else { *(f32x4*)(hout + off + bj * HALF + n * 16) = h; *(u32x2*)(nout + off + bj * HALF + n * 16) = pack4(h * rinv * gg); } }
                }
    }
};

template <class Epi, class Sched>
__device__ __forceinline__ void gemm_phase(LAS unsigned char* lds, const Gemm g, const Sched& S, const Epi& E) {
    const int tid = otid(), wid = __builtin_amdgcn_readfirstlane(tid >> 6), lane = tid & 63, wr = wid >> 2, wc = wid & 3, fr = lane & 15, fq = lane >> 4;
    const int K = g.K, nt = K / BK;
    unsigned voffA[2], voffB[2];
#pragma unroll
    for (int i = 0; i < 2; ++i) { int R, C; stage_rc(tid * 16 + i * 8192, R, C); const int Rb = Epi::PERM ? ((R & ~31) + perm32(R & 31)) : R;
        voffA[i] = (unsigned)(R * g.lda + C) * 2u; voffB[i] = (unsigned)(Rb * g.ldb + C) * 2u; }
    const size_t kstep = (size_t)(BK * 2);
    const size_t hstepA = (size_t)HALF * g.lda * 2, hstepB = (size_t)HALF * g.ldb * 2;
    const size_t tstepA = 2 * hstepA, tstepB = 2 * hstepB;
    const unsigned ldsw = (unsigned)wid * 1024u;
    const int aoff = lds_byte(wr * 64 + fr, fq * 8), boff = lds_byte(wc * 32 + fr, fq * 8);
#define PG8_SA(b, h) (((b) * 2 + (h)) * HTB)
#define PG8_SB(b, h) ((4 + (b) * 2 + (h)) * HTB)
#define PG8_STAGE(bufoff, gbase, voff) do { _Pragma("unroll") for (int _i = 0; _i < 2; ++_i) \
        __builtin_amdgcn_global_load_lds((const unsigned*)((const char*)(gbase) + (voff)[_i]), (LAS unsigned*)(lds + (bufoff) + ldsw + _i * 8192), 16, 0, 0); } while (0)
#define PG8_LDA(dst, b, h) do { _Pragma("unroll") for (int m = 0; m < 4; ++m) _Pragma("unroll") for (int k = 0; k < 2; ++k) dst[m][k] = *(const LAS bf16x8*)(lds + PG8_SA(b, h) + aoff + m * 2048 + k * 1024); } while (0)
#define PG8_LDB(dst, b, h) do { _Pragma("unroll") for (int n = 0; n < 2; ++n) _Pragma("unroll") for (int k = 0; k < 2; ++k) dst[n][k] = *(const LAS bf16x8*)(lds + PG8_SB(b, h) + boff + n * 2048 + k * 1024); } while (0)
#define PG8_MMA(ai, bj, At, Bt) do { __builtin_amdgcn_s_setprio(1); _Pragma("unroll") for (int m = 0; m < 4; ++m) _Pragma("unroll") for (int n = 0; n < 2; ++n) _Pragma("unroll") for (int k = 0; k < 2; ++k) \
        acc[ai][bj][m][n] = __builtin_amdgcn_mfma_f32_16x16x32_bf16(Bt[n][k], At[m][k], acc[ai][bj][m][n], 0, 0, 0); __builtin_amdgcn_s_setprio(0); } while (0)
#define PG8_WAIT_V(n) asm volatile("s_waitcnt vmcnt(" #n ")" ::: "memory")
#define PG8_WAIT_L(n) asm volatile("s_waitcnt lgkmcnt(" #n ")" ::: "memory")
#define PG8_BAR __builtin_amdgcn_s_barrier()
#define PG8_SCHED __builtin_amdgcn_sched_barrier(0)
    Unit cur, nxt; int ui = 0;
    if (!S.next(0, cur)) return;
    f32x4 acc[2][2][4][2];
    if constexpr (Epi::ACC_INIT) E.init(acc, cur, wr, wc, fr, fq);
    else {
#pragma unroll
    for (int a = 0; a < 2; ++a)
#pragma unroll
        for (int b = 0; b < 2; ++b)
#pragma unroll
            for (int m = 0; m < 4; ++m)
#pragma unroll
                for (int n = 0; n < 2; ++n) acc[a][b][m][n] = (f32x4){0.f, 0.f, 0.f, 0.f};
    }
    bf16x8 At[4][2], B0[2][2], B1[2][2];
    const char* cA = (const char*)g.A + (size_t)cur.pm * tstepA; const char* cB = (const char*)g.Bt + (size_t)cur.pn * tstepB;
    PG8_STAGE(PG8_SB(0, 0), cB, voffB); PG8_STAGE(PG8_SA(0, 0), cA, voffA); PG8_STAGE(PG8_SB(0, 1), cB + hstepB, voffB); PG8_STAGE(PG8_SA(0, 1), cA + hstepA, voffA);
    if (wr == 1) PG8_BAR;
    PG8_WAIT_V(4); PG8_BAR;
    PG8_STAGE(PG8_SB(1, 0), cB + kstep, voffB); PG8_STAGE(PG8_SA(1, 0), cA + kstep, voffA); PG8_STAGE(PG8_SB(1, 1), cB + hstepB + kstep, voffB);
    PG8_WAIT_V(6); PG8_BAR;
    for (;;) {
        const bool has_next = S.next(ui + 1, nxt);
        const char* nA = has_next ? (const char*)g.A + (size_t)nxt.pm * tstepA : cA; const char* nB = has_next ? (const char*)g.Bt + (size_t)nxt.pn * tstepB : cB;
        for (int t = 0; t < nt; t += 2) {
            const bool last = (t == nt - 2);
            const char* a1 = cA + (size_t)(t + 1) * kstep;
            const char* a2 = last ? nA : cA + (size_t)(t + 2) * kstep; const char* b2 = last ? nB : cB + (size_t)(t + 2) * kstep;
            const char* a3 = a2 + kstep; const char* b3 = b2 + kstep;
            PG8_LDB(B0, 0, 0); PG8_SCHED; PG8_LDA(At, 0, 0); PG8_STAGE(PG8_SA(1, 1), a1 + hstepA, voffA);
            PG8_WAIT_L(8); PG8_BAR; PG8_WAIT_L(0); PG8_MMA(0, 0, At, B0); PG8_BAR; PG8_SCHED;
            PG8_LDB(B1, 0, 1); PG8_STAGE(PG8_SB(0, 0), b2, voffB);
            PG8_BAR; PG8_WAIT_L(0); PG8_MMA(0, 1, At, B1); PG8_BAR;
            PG8_LDA(At, 0, 1); PG8_STAGE(PG8_SA(0, 0), a2, voffA);
            PG8_BAR; PG8_WAIT_L(0); PG8_MMA(1, 0, At, B0); PG8_BAR; PG8_SCHED;
            PG8_STAGE(PG8_SB(0, 1), b2 + hstepB, voffB);
            PG8_WAIT_V(6); PG8_BAR; PG8_MMA(1, 1, At, B1); PG8_BAR;
            PG8_LDB(B0, 1, 0); PG8_SCHED; PG8_LDA(At, 1, 0); PG8_STAGE(PG8_SA(0, 1), a2 + hstepA, voffA);
            PG8_WAIT_L(8); PG8_BAR; PG8_WAIT_L(0); PG8_MMA(0, 0, At, B0); PG8_BAR; PG8_SCHED;
            PG8_LDB(B1, 1, 1); PG8_STAGE(PG8_SB(1, 0), b3, voffB);
            PG8_BAR; PG8_WAIT_L(0); PG8_MMA(0, 1, At, B1); PG8_BAR;
            PG8_LDA(At, 1, 1); PG8_STAGE(PG8_SA(1, 0), a3, voffA);
            PG8_BAR; PG8_WAIT_L(0); PG8_MMA(1, 0, At, B0); PG8_BAR; PG8_SCHED;
            PG8_STAGE(PG8_SB(1, 1), b3 + hstepB, voffB);
            PG8_WAIT_V(6); PG8_BAR; PG8_MMA(1, 1, At, B1); PG8_BAR;
        }
        if constexpr (!Epi::AFTER_DRAIN) E(acc, cur, wr, wc, fr, fq);
        if (!has_next) break;
#pragma unroll
        for (int a = 0; a < 2; ++a)
#pragma unroll
            for (int b = 0; b < 2; ++b)
#pragma unroll
                for (int m = 0; m < 4; ++m)
#pragma unroll
                    for (int n = 0; n < 2; ++n) acc[a][b][m][n] = (f32x4){0.f, 0.f, 0.f, 0.f};
        cur = nxt; cA = nA; cB = nB; ++ui;
    }
    PG8_WAIT_V(0);
    if (wr == 0) PG8_BAR;
    PG8_BAR;
    if constexpr (Epi::AFTER_DRAIN) E.fused(acc, cur, wr, wc, fr, fq, lds, wid, lane);
#undef PG8_SA
#undef PG8_SB
#undef PG8_STAGE
#undef PG8_LDA
#undef PG8_LDB
#undef PG8_MMA
#undef PG8_WAIT_V
#undef PG8_WAIT_L
#undef PG8_BAR
#undef PG8_SCHED
}
}

constexpr int AT_KSTR = 272, AT_VSTR = 288, AT_VOFF = 256 * AT_KSTR;
struct AttnRegs { u32x4 k[8], v[8]; bf16x8 q[4]; };
__device__ __forceinline__ void attn_decode(int u, int& p, int& b, int& h, int& r, int& blk) {
    const int bh = u / 48, w = u % 48; b = bh >> 3; h = bh & 7;
    if (w < 16) { p = 0; r = 0; blk = w; } else if (w < 32) { p = 1; r = (w - 16) >> 2; blk = (w - 16) & 3; } else { p = 2; r = w - 32; blk = 0; }
}
__device__ __forceinline__ void attn_issue(const bf16_t* __restrict__ Z, int u, AttnRegs& R, int tid) {
    int p, b, h, r, nb; attn_decode(u, p, b, h, r, nb);
    const int d = (p == 0) ? 1 : (p == 1 ? 4 : 16), kidx0 = nb * 128 - 128;
    const int wid = tid >> 6, lane = tid & 63, fr = lane & 15, fq = lane >> 4;
#pragma unroll
    for (int i = 0; i < 8; ++i) { const int id = tid + 512 * i, key = id >> 4, ch = id & 15, kidx = kidx0 + key;
        R.k[i] = (u32x4){0u, 0u, 0u, 0u}; R.v[i] = (u32x4){0u, 0u, 0u, 0u};
        if (kidx >= 0) { const bf16_t* rowp = Z + (size_t)(b * SEQ + kidx * d + r) * LDZ0; R.k[i] = *(const u32x4*)(rowp + 1024 + h * 128 + ch * 8); R.v[i] = *(const u32x4*)(rowp + 2048 + h * 128 + ch * 8); } }
    const int qi = wid * 16 + fr, qpos = (nb * 128 + qi) * d + r;
    const bf16_t* qrow = Z + (size_t)(b * SEQ + qpos) * LDZ0 + h * 128;
#pragma unroll
    for (int s = 0; s < 4; ++s) R.q[s] = *(const bf16x8*)(qrow + 32 * s + 8 * fq);
}
__device__ __forceinline__ void attn_unit(const bf16_t* __restrict__ Z, bf16_t* __restrict__ OP, float* __restrict__ LSE, unsigned char* lds, int u, int unext, AttnRegs& R) {
    const int tid = otid(), wid = tid >> 6, lane = tid & 63, fr = lane & 15, fq = lane >> 4;
    int p, b, h, r, nb; attn_decode(u, p, b, h, r, nb);
    const int d = (p == 0) ? 1 : (p == 1 ? 4 : 16);
    const int kidx0 = nb * 128 - 128;
    __syncthreads();
#pragma unroll
    for (int i = 0; i < 8; ++i) { const int id = tid + 512 * i, key = id >> 4, ch = id & 15;
        *(u32x4*)(lds + key * AT_KSTR + ch * 16) = R.k[i]; *(u32x4*)(lds + AT_VOFF + key * AT_VSTR + ch * 16) = R.v[i]; }
    if (tid < 288) *(u32x4*)(lds + AT_VOFF + 256 * AT_VSTR + tid * 16) = (u32x4){0u, 0u, 0u, 0u};
    const int qi = wid * 16 + fr, qpos = (nb * 128 + qi) * d + r;
    bf16x8 qf[4];
#pragma unroll
    for (int s = 0; s < 4; ++s) qf[s] = R.q[s];
    if (unext >= 0) attn_issue(Z, unext, R, tid);
    __syncthreads();
    f32x4 sc[10];
    const int widu = __builtin_amdgcn_readfirstlane(wid);
    const bool firstblk = (nb == 0);
#pragma unroll
    for (int kt = 0; kt < 9; ++kt) { sc[kt] = (f32x4){0.f, 0.f, 0.f, 0.f};
        if (!firstblk || widu + kt >= 8) {
#pragma unroll
        for (int s = 0; s < 4; ++s) { const bf16x8 kf = *(const bf16x8*)(lds + (16 * (wid + kt) + fr) * AT_KSTR + (32 * s + 8 * fq) * 2); sc[kt] = mfma16(kf, qf[s], sc[kt]); } } }
    sc[9] = (f32x4){0.f, 0.f, 0.f, 0.f};
    const float NEG = -__builtin_inff();
    float m = -1e30f;
#pragma unroll
    for (int kt = 0; kt < 9; ++kt) { const bool tile_ok = (nb != 0) || (wid + kt >= 8);
#pragma unroll
        for (int ri = 0; ri < 4; ++ri) { bool valid = tile_ok;
            if (kt == 0) valid = valid && (4 * fq + ri >= fr);
            if (kt == 8) valid = valid && (4 * fq + ri <= fr);
            const float s = valid ? sc[kt][ri] : NEG; sc[kt][ri] = s; m = fmaxf(m, s); } }
    m = fmaxf(m, __shfl_xor(m, 16)); m = fmaxf(m, __shfl_xor(m, 32));
    constexpr float C2 = 0.08838834764831845f * 1.4426950408889634f;
    const float mC = -m * C2;
    float l = 0.f;
#pragma unroll
    for (int kt = 0; kt < 9; ++kt)
#pragma unroll
        for (int ri = 0; ri < 4; ++ri) { const float e = __builtin_amdgcn_exp2f(fmaf(sc[kt][ri], C2, mC)); sc[kt][ri] = e; l += e; }
    l += __shfl_xor(l, 16); l += __shfl_xor(l, 32);
    f32x4 o[8];
#pragma unroll
    for (int et = 0; et < 8; ++et) o[et] = (f32x4){0.f, 0.f, 0.f, 0.f};
    const int q4 = fr >> 2, p4 = fr & 3;
    const unsigned char* vbase = lds + AT_VOFF + (16 * wid + 4 * fq + q4) * AT_VSTR + 8 * p4;
#pragma unroll
    for (int st = 0; st < 5; ++st) {
        if (firstblk && widu + 2 * st + 1 < 8) continue;
        const u32x2 plo = pack4(sc[2 * st]), phi = pack4(sc[2 * st + 1]);
        u32x4 pw = {plo.x, plo.y, phi.x, phi.y}; const bf16x8 pb = *reinterpret_cast<bf16x8*>(&pw);
#pragma unroll
        for (int et = 0; et < 8; ++et) {
            const s16x4 lo = __builtin_amdgcn_ds_read_tr16_b64_v4i16((LAS s16x4*)(vbase + (32 * st) * AT_VSTR + et * 32));
            const s16x4 hi = __builtin_amdgcn_ds_read_tr16_b64_v4i16((LAS s16x4*)(vbase + (32 * st + 16) * AT_VSTR + et * 32));
            const bf16x8 va = {lo[0], lo[1], lo[2], lo[3], hi[0], hi[1], hi[2], hi[3]};
            o[et] = mfma16(va, pb, o[et]); }
    }
    const float inv = 1.0f / l; const size_t token = (size_t)b * SEQ + qpos;
    bf16_t* orow = OP + (size_t)p * NTOK * 1024 + token * 1024 + h * 128 + 4 * fq;
#pragma unroll
    for (int et = 0; et < 8; ++et) *(u32x2*)(orow + 16 * et) = pack4(o[et] * inv);
    if (fq == 0) LSE[((size_t)p * NTOK + token) * 8 + h] = m * 0.08838834764831845f + __logf(l);
}

template <bool HG> __device__ __forceinline__ bf16_t* us_chunk(unsigned char* ws, int c) {
    if (!HG) return (bf16_t*)(ws + WS_HN) + (size_t)c * 256 * 128;
    return (c < 512) ? (bf16_t*)(ws + WS_WT_IN1) + (size_t)c * 128 * 128 : (bf16_t*)(ws + WS_OB) + (size_t)(c - 512) * 128 * 128;
}
constexpr size_t WS_DV = WS_END, WS_EMV = WS_END + 524288, WS_BAR = WS_END + 1048576, WS_CNT = WS_BAR + 16384, WS_XS = WS_BAR + 32768, WS_TOP = WS_XS + 524288;
struct GlrRegs { u32x4 k[2], q[2], v[4], gl, s[8]; float wg[16], bg, g0, g1; };
template <bool HG, bool PC>
__device__ __forceinline__ void glr_issue(const Params& P, int cc, GlrRegs& R, int tid) {
    constexpr int V = HG ? 128 : 256, VCH = V / 8;
    const int bh = cc >> 5, n = cc & 31;
    const int b = HG ? (bh >> 3) : (bh >> 2), h = HG ? (bh & 7) : (bh & 3);
    const bf16_t* Zb = (const bf16_t*)(P.ws + WS_Z); const int ld = HG ? LDZ1 : LDZ0;
    const int qcol = HG ? h * 128 : 3072 + h * 128, kcol = HG ? 1024 + h * 128 : 3584 + h * 128, vcol = HG ? 2048 + h * 128 : 4096 + h * 256;
    const size_t row0 = (size_t)b * SEQ + n * 64;
#pragma unroll
    for (int i = 0; i < 2; ++i) { const int id = tid + 512 * i, t = id >> 4, ch = id & 15; const bf16_t* rowp = Zb + (row0 + t) * ld;
        R.k[i] = *(const u32x4*)(rowp + kcol + ch * 8);
        if (PC) R.q[i] = *(const u32x4*)(rowp + qcol + ch * 8); }
#pragma unroll
    for (int i = 0; i < V / 64; ++i) { const int id = tid + 512 * i, t = id / VCH, ch = id % VCH;
        R.v[i] = *(const u32x4*)(Zb + (row0 + t) * ld + vcol + ch * 8); }
    if (!HG && tid < 128) { const int t = tid >> 1, hf = tid & 1; R.gl = *(const u32x4*)(Zb + (row0 + t) * ld + 7168 + hf * 8); }
    { const int kc = tid & 127;
      if (!HG) {
#pragma unroll
          for (int r = 0; r < 16; ++r) R.wg[r] = P.gla_w_gate[r * 512 + h * 128 + kc];
          R.bg = P.gla_b_gate[h * 128 + kc];
      } else { R.g0 = P.hgrn_gamma[h * 128 + kc]; R.g1 = P.hgrn_gamma[1024 + h * 128 + kc]; } }
    if (PC) { const bf16_t* usp = us_chunk<HG>(P.ws, cc);
#pragma unroll
        for (int i = 0; i < V / 32; ++i) R.s[i] = *(const u32x4*)(usp + (size_t)(tid + 512 * i) * 8); }
}
template <bool HG, bool PC>
__device__ __forceinline__ void glr_chunk(const Params& P, unsigned char* lds, int cc, int cnext, GlrRegs& R) {
    const int bh = cc >> 5, n = cc & 31;
    constexpr int V = HG ? 128 : 256, VSTR = HG ? 288 : 544, VCH = V / 8;
    unsigned char* RK = lds; unsigned char* RQ = lds + 17408; unsigned char* VV = lds + 34816; bf16_t* SC = (bf16_t*)(lds + 69632);
    float* PART = (float*)(lds + 78848); float* EM = (float*)(lds + 80896); float* ELM = EM + 128; unsigned char* GLb = lds + 82432;
    bf16_t* Ks = (bf16_t*)RK; bf16_t* Qs = (bf16_t*)RQ;
    const int tid = otid(), wid = tid >> 6, lane = tid & 63, fr = lane & 15, fq = lane >> 4, q4 = fr >> 2, p4 = fr & 3;
    const int b = HG ? (bh >> 3) : (bh >> 2), h = HG ? (bh & 7) : (bh & 3);
    const bf16_t* Zb = (const bf16_t*)(P.ws + WS_Z); const int ld = HG ? LDZ1 : LDZ0;
    const int qcol = HG ? h * 128 : 3072 + h * 128, kcol = HG ? 1024 + h * 128 : 3584 + h * 128;
    const int vcol = HG ? 2048 + h * 128 : 4096 + h * 256, ocol = HG ? h * 128 : h * 256;
    float* DV = (float*)(P.ws + WS_DV); float* EMV = (float*)(P.ws + WS_EMV);
    const int c = bh * 32 + n;
    bf16_t* USc = us_chunk<HG>(P.ws, c);
    const size_t row0 = (size_t)b * SEQ + n * 64;
    const int kc = tid & 127, tq = tid >> 7;
    __syncthreads();
#pragma unroll
    for (int i = 0; i < 2; ++i) { const int id = tid + 512 * i, t = id >> 4, ch = id & 15;
        *(u32x4*)(RK + t * 272 + ch * 16) = R.k[i];
        if (PC) *(u32x4*)(RQ + t * 272 + ch * 16) = R.q[i]; }
#pragma unroll
    for (int i = 0; i < V / 64; ++i) { const int id = tid + 512 * i, t = id / VCH, ch = id % VCH;
        *(u32x4*)(VV + t * VSTR + ch * 16) = R.v[i]; }
    if (!HG && tid < 128) { const int t = tid >> 1, hf = tid & 1; *(u32x4*)(GLb + t * 32 + hf * 16) = R.gl; }
    unsigned char* SS = lds + 84480;
    if (PC) {
#pragma unroll
        for (int i = 0; i < V / 32; ++i) { const int id = tid + 512 * i; *(u32x4*)(SS + (id >> 4) * 272 + (id & 15) * 16) = R.s[i]; } }
    unsigned wgp[8]; float bgk = 0.f, lbk = 0.f;
    if (!HG) {
#pragma unroll
        for (int r = 0; r < 8; ++r) wgp[r] = cvt_pk_bf16(R.wg[2 * r], R.wg[2 * r + 1]);
        bgk = R.bg;
    } else {
#pragma unroll
        for (int r = 0; r < 8; ++r) wgp[r] = 0u;
        lbk = sigmoidf_(R.g1 - R.g0);
    }
    if (cnext >= 0) glr_issue<HG, PC>(P, cnext, R, tid);
    __syncthreads();
    float qv[16], kv[16], lg[16];
#pragma unroll
    for (int i = 0; i < 16; ++i) { const int t = tq * 16 + i;
        const float kraw = bf2f(Ks[t * 136 + kc]); const float qraw = PC ? bf2f(Qs[t * 136 + kc]) : 0.f;
        if (HG) { const float f = lbk + (1.0f - lbk) * sigmoidf_(kraw); lg[i] = __logf(f); kv[i] = 1.0f - f; qv[i] = siluf_(qraw); }
        else { const u32x4 g0 = *(const u32x4*)(GLb + t * 32), g1 = *(const u32x4*)(GLb + t * 32 + 16);
            float x = bgk;
            x = dot2bf(g0.x, wgp[0], x); x = dot2bf(g0.y, wgp[1], x); x = dot2bf(g0.z, wgp[2], x); x = dot2bf(g0.w, wgp[3], x);
            x = dot2bf(g1.x, wgp[4], x); x = dot2bf(g1.y, wgp[5], x); x = dot2bf(g1.z, wgp[6], x); x = dot2bf(g1.w, wgp[7], x);
            lg[i] = logsigmoidf_(x) * (1.0f / 16.0f); kv[i] = kraw; qv[i] = qraw * 0.08838834764831845f; } }
    float run = 0.f;
#pragma unroll
    for (int i = 0; i < 16; ++i) { run += lg[i]; lg[i] = run; }
    PART[tq * 128 + kc] = run;
    __syncthreads();
    const float p0 = PART[kc], p1 = PART[128 + kc], p2 = PART[256 + kc], p3 = PART[384 + kc];
    const float off = (tq > 0 ? p0 : 0.f) + (tq > 1 ? p1 : 0.f) + (tq > 2 ? p2 : 0.f);
    const float bmid = p0 + p1, blast = bmid + p2 + p3;
#pragma unroll
    for (int i = 0; i < 16; ++i) { const float bt = off + lg[i]; const int t = tq * 16 + i;
        Ks[t * 136 + kc] = f2bf(kv[i] * __expf(bmid - bt));
        if (PC) Qs[t * 136 + kc] = f2bf(qv[i] * __expf(bt - bmid)); }
    if (!PC && tq == 0) { ELM[kc] = __expf(blast - bmid); DV[(size_t)c * 128 + kc] = __expf(blast); EMV[(size_t)c * 128 + kc] = __expf(bmid); }
    __syncthreads();
    if (!PC) {
        const int k0 = 16 * wid;
        const unsigned char* abase = RK + (8 * fq + q4) * 272 + (k0 + 4 * p4) * 2;
        bf16x8 af[2];
#pragma unroll
        for (int s = 0; s < 2; ++s) { const s16x4 lo = __builtin_amdgcn_ds_read_tr16_b64_v4i16((LAS s16x4*)(abase + (32 * s) * 272));
            const s16x4 hi = __builtin_amdgcn_ds_read_tr16_b64_v4i16((LAS s16x4*)(abase + (32 * s + 4) * 272));
            af[s] = (bf16x8){lo[0], lo[1], lo[2], lo[3], hi[0], hi[1], hi[2], hi[3]}; }
        const f32x4 el = *(const f32x4*)(ELM + k0 + 4 * fq);
#pragma unroll
        for (int vt = 0; vt < V / 16; ++vt) { f32x4 a = {0.f, 0.f, 0.f, 0.f};
            const unsigned char* bbase = VV + (8 * fq + q4) * VSTR + (16 * vt + 4 * p4) * 2;
#pragma unroll
            for (int s = 0; s < 2; ++s) { const s16x4 lo = __builtin_amdgcn_ds_read_tr16_b64_v4i16((LAS s16x4*)(bbase + (32 * s) * VSTR));
                const s16x4 hi = __builtin_amdgcn_ds_read_tr16_b64_v4i16((LAS s16x4*)(bbase + (32 * s + 4) * VSTR));
                const bf16x8 bfv = {lo[0], lo[1], lo[2], lo[3], hi[0], hi[1], hi[2], hi[3]}; a = mfma16(af[s], bfv, a); }
            *(u32x2*)(USc + (size_t)(16 * vt + fr) * 128 + k0 + 4 * fq) = pack4(a * el); }
    } else {
        const float* ng = HG ? P.hgrn_norm_g : P.gla_norm_g;
        const size_t trow = row0 + 16 * (wid & 3) + fr; const bf16_t* grow = Zb + trow * ld + (HG ? 4096 : 6144) + ocol;
        u32x2 gwv[V / 32]; f32x4 gnv[V / 32];
#pragma unroll
        for (int i = 0; i < V / 32; ++i) { const int v0 = 16 * ((wid >> 2) + 2 * i) + 4 * fq; gwv[i] = *(const u32x2*)(grow + v0); gnv[i] = *(const f32x4*)(ng + ocol + v0); }
        { const int it = wid & 3;
#pragma unroll
          for (int jj = 0; jj < 2; ++jj) { const int jt = 2 * (wid >> 2) + jj; f32x4 a = {0.f, 0.f, 0.f, 0.f};
#pragma unroll
              for (int s = 0; s < 4; ++s) { const bf16x8 afr = *(const bf16x8*)(Ks + (16 * jt + fr) * 136 + 32 * s + 8 * fq); const bf16x8 bfv = *(const bf16x8*)(Qs + (16 * it + fr) * 136 + 32 * s + 8 * fq); a = mfma16(afr, bfv, a); }
              const int i = 16 * it + fr, j0 = 16 * jt + 4 * fq;
#pragma unroll
              for (int ri = 0; ri < 4; ++ri) a[ri] = (j0 + ri <= i) ? a[ri] : 0.f;
              *(u32x2*)(SC + i * 72 + j0) = pack4(a); } }
        __syncthreads();
        const int tt = wid & 3;
        bf16x8 qb[4], sb[2];
#pragma unroll
        for (int s = 0; s < 4; ++s) qb[s] = *(const bf16x8*)(Qs + (16 * tt + fr) * 136 + 32 * s + 8 * fq);
#pragma unroll
        for (int s = 0; s < 2; ++s) sb[s] = *(const bf16x8*)(SC + (16 * tt + fr) * 72 + 32 * s + 8 * fq);
        f32x4 acc[V / 32]; float ss = 0.f;
#pragma unroll
        for (int i = 0; i < V / 32; ++i) { const int vt = (wid >> 2) + 2 * i; f32x4 a = {0.f, 0.f, 0.f, 0.f};
            const unsigned char* sp = SS + (16 * vt + fr) * 272 + 16 * fq;
#pragma unroll
            for (int s = 0; s < 4; ++s) { const bf16x8 afr = *(const bf16x8*)(sp + 64 * s); a = mfma16(afr, qb[s], a); }
            const unsigned char* vb = VV + (8 * fq + q4) * VSTR + (16 * vt + 4 * p4) * 2;
#pragma unroll
            for (int s = 0; s < 2; ++s) { const s16x4 lo = __builtin_amdgcn_ds_read_tr16_b64_v4i16((LAS s16x4*)(vb + (32 * s) * VSTR));
                const s16x4 hi = __builtin_amdgcn_ds_read_tr16_b64_v4i16((LAS s16x4*)(vb + (32 * s + 4) * VSTR));
                const bf16x8 afr = {lo[0], lo[1], lo[2], lo[3], hi[0], hi[1], hi[2], hi[3]}; a = mfma16(afr, sb[s], a); }
            acc[i] = a; ss += a[0] * a[0] + a[1] * a[1] + a[2] * a[2] + a[3] * a[3]; }
        ss += __shfl_xor(ss, 16); ss += __shfl_xor(ss, 32);
        if (fq == 0) PART[(wid >> 2) * 64 + 16 * tt + fr] = ss;
        __syncthreads();
        const float tot = PART[16 * tt + fr] + PART[64 + 16 * tt + fr];
        const float rinv = rsqrtf(tot * (1.0f / V) + 1e-6f);
        bf16_t* Yb = (bf16_t*)(P.ws + (HG ? WS_HN : WS_OB));
#pragma unroll
        for (int i = 0; i < V / 32; ++i) { const int vt = (wid >> 2) + 2 * i, v0 = 16 * vt + 4 * fq;
            const u32x2 gw = gwv[i]; const f32x4 gn = gnv[i];
            f32x4 y; y[0] = acc[i][0] * rinv * gn[0] * siluf_(lo_bf(gw.x)); y[1] = acc[i][1] * rinv * gn[1] * siluf_(hi_bf(gw.x));
            y[2] = acc[i][2] * rinv * gn[2] * siluf_(lo_bf(gw.y)); y[3] = acc[i][3] * rinv * gn[3] * siluf_(hi_bf(gw.y));
            *(u32x2*)(Yb + trow * DM + 1024 + ocol + v0) = pack4(y); }
    }
}
template <bool HG>
__device__ __forceinline__ void glr_scan(const Params& P, int bid, int nb, int t0 = 0, int nt = 512) {
    constexpr int V = HG ? 128 : 256;
    const float* __restrict__ DV = (const float*)(P.ws + WS_DV); const float* __restrict__ EMV = (const float*)(P.ws + WS_EMV);
    const int tid = otid();
    for (int gid = bid * nt + tid - t0; gid < 131072; gid += nb * nt) {
        const int kq = gid & 31, v = (gid >> 5) % V, bh = gid / (32 * V);
        f32x4 S = {0.f, 0.f, 0.f, 0.f};
        for (int n0 = 0; n0 < 32; n0 += 16) { u32x2 uw[16]; f32x4 d[16], em[16];
#pragma unroll
            for (int j = 0; j < 16; ++j) { const size_t c = (size_t)bh * 32 + n0 + j; uw[j] = *(const u32x2*)(us_chunk<HG>(P.ws, (int)c) + (size_t)v * 128 + 4 * kq);
                d[j] = *(const f32x4*)(DV + c * 128 + 4 * kq); em[j] = *(const f32x4*)(EMV + c * 128 + 4 * kq); }
#pragma unroll
            for (int j = 0; j < 16; ++j) { const size_t c = (size_t)bh * 32 + n0 + j;
                *(u32x2*)(us_chunk<HG>(P.ws, (int)c) + (size_t)v * 128 + 4 * kq) = pack4(S * em[j]);
                const f32x4 u = {lo_bf(uw[j].x), hi_bf(uw[j].x), lo_bf(uw[j].y), hi_bf(uw[j].y)};
                S = S * d[j] + u; } }
    }
}

__device__ __forceinline__ void gate_l0(const Params& P, int bid, int nb, int w0 = 0, int nw = 8) {
    const int tid_ = otid(); const int wid = (tid_ >> 6) - w0, lane = tid_ & 63;
    const bf16_t* __restrict__ OP = (const bf16_t*)P.out; const float* __restrict__ LSE = (const float*)((const unsigned char*)P.out + DO_LSE);
    const bf16_t* __restrict__ Z = (const bf16_t*)(P.ws + WS_Z); bf16_t* __restrict__ Y = (bf16_t*)(P.ws + WS_OB);
#pragma unroll 2
    for (int token = bid * nw + wid; token < NTOK; token += nb * nw) {
        {
            const int c0 = lane * 16, head = lane >> 3;
            const float l0 = LSE[((size_t)0 * NTOK + token) * 8 + head], l1 = LSE[((size_t)1 * NTOK + token) * 8 + head], l2 = LSE[((size_t)2 * NTOK + token) * 8 + head];
            const float mx = fmaxf(l0, fmaxf(l1, l2)); float w0 = __expf(l0 - mx), w1 = __expf(l1 - mx), w2 = __expf(l2 - mx); const float ws = 1.0f / (w0 + w1 + w2); w0 *= ws; w1 *= ws; w2 *= ws;
#pragma unroll
            for (int hf = 0; hf < 2; ++hf) { const int c = c0 + hf * 8;
                const u32x4 a = *(const u32x4*)(OP + (size_t)token * 1024 + c), bq = *(const u32x4*)(OP + ((size_t)NTOK + token) * 1024 + c), cq = *(const u32x4*)(OP + ((size_t)2 * NTOK + token) * 1024 + c);
                const u32x4 gv = *(const u32x4*)(Z + (size_t)token * LDZ0 + 5120 + c);
                const unsigned aw[4] = {a.x, a.y, a.z, a.w}, bw[4] = {bq.x, bq.y, bq.z, bq.w}, cw[4] = {cq.x, cq.y, cq.z, cq.w}, gw[4] = {gv.x, gv.y, gv.z, gv.w};
                unsigned ow[4];
#pragma unroll
                for (int i = 0; i < 4; ++i) { const float ylo = (w0 * lo_bf(aw[i]) + w1 * lo_bf(bw[i]) + w2 * lo_bf(cw[i])) * siluf_(lo_bf(gw[i])); const float yhi = (w0 * hi_bf(aw[i]) + w1 * hi_bf(bw[i]) + w2 * hi_bf(cw[i])) * siluf_(hi_bf(gw[i])); ow[i] = cvt_pk_bf16(ylo, yhi); }
                *(u32x4*)(Y + (size_t)token * DM + c) = (u32x4){ow[0], ow[1], ow[2], ow[3]}; }
        }
    }
}
__device__ __forceinline__ void s5_disc(const Params& P, int g, int p, float& lr, float& li, float& dt, float& cor, float& coi) {
    lr = P.lam_re[g * 64 + p]; li = P.lam_im[g * 64 + p]; dt = __expf(P.log_dt[g]);
    const float mag = __expf(lr * dt), ang = li * dt; const float ar = mag * __cosf(ang), ai = mag * __sinf(ang);
    const float inv = 1.0f / (lr * lr + li * li); const float nr = ar - 1.0f, ni = ai;
    cor = (nr * lr + ni * li) * inv; coi = (ni * lr - nr * li) * inv;
}
__device__ __forceinline__ void s5_gen(const Params& P, unsigned char* lds, int bid, int nb) {
    float* AP = (float*)lds;
    float* CC = AP + 384;
    float* BB = CC + 2048;
    float* KT = BB + 2048;
    bf16_t* E = (bf16_t*)(P.ws + WS_S5B1); bf16_t* TF = (bf16_t*)(P.ws + WS_S5B2);
    const int tid = otid();
    for (int item = bid; item < 256; item += nb) {
        const int g = item >> 2;
        __syncthreads();
#pragma unroll
        for (int rep = 0; rep < 2; ++rep) { const int idx = tid + rep * 512;
            { const int p = idx >> 4, hp = idx & 15; float lr, li, dt, cr, ci; s5_disc(P, g, p, lr, li, dt, cr, ci);
              const float br = P.b_re[(g * 64 + p) * 16 + hp], bi = P.b_im[(g * 64 + p) * 16 + hp];
              BB[idx * 2] = cr * br - ci * bi; BB[idx * 2 + 1] = cr * bi + ci * br; }
            { const int hh = idx >> 6, p = idx & 63; CC[idx * 2] = P.c_re[(g * 16 + hh) * 64 + p]; CC[idx * 2 + 1] = P.c_im[(g * 16 + hh) * 64 + p]; } }
        float lrp = 0.f, lip = 0.f, dtp = 0.f;
        if (tid < 64) { float cr, ci; s5_disc(P, g, tid, lrp, lip, dtp, cr, ci); }
        for (int tt = 0; tt < 4; ++tt) { const int tau = (item & 3) * 4 + tt;
        if (tid < 64) { const int e3[3] = {tau, tau + 1, 15 - tau};
#pragma unroll
            for (int q = 0; q < 3; ++q) { const float mg = __expf(lrp * dtp * (float)e3[q]), an = lip * dtp * (float)e3[q]; AP[(q * 64 + tid) * 2] = mg * __cosf(an); AP[(q * 64 + tid) * 2 + 1] = mg * __sinf(an); } }
        __syncthreads();
        if (tid < 256) { const int hh = tid >> 4, hp = tid & 15; float s = 0.f;
            for (int p = 0; p < 64; ++p) { const float cr = CC[(hh * 64 + p) * 2], ci = CC[(hh * 64 + p) * 2 + 1], ar = AP[p * 2], ai = AP[p * 2 + 1];
                const float t1r = cr * ar - ci * ai, t1i = cr * ai + ci * ar; s += t1r * BB[(p * 16 + hp) * 2] - t1i * BB[(p * 16 + hp) * 2 + 1]; }
            if (tau == 0 && hh == hp) s += P.s5_d[g * 16 + hh];
            KT[tid] = s;
        } else { const int u = tid - 256;
            {
                const int hh = u >> 4, pg = u & 15; float vals[8];
#pragma unroll
                for (int q = 0; q < 4; ++q) { const int p = pg * 4 + q; const float cr = CC[(hh * 64 + p) * 2], ci = CC[(hh * 64 + p) * 2 + 1], ar = AP[(64 + p) * 2], ai = AP[(64 + p) * 2 + 1];
                    vals[2 * q] = cr * ar - ci * ai; vals[2 * q + 1] = -(cr * ai + ci * ar); }
                u32x4 w; w.x = cvt_pk_bf16(vals[0], vals[1]); w.y = cvt_pk_bf16(vals[2], vals[3]); w.z = cvt_pk_bf16(vals[4], vals[5]); w.w = cvt_pk_bf16(vals[6], vals[7]);
                *(u32x4*)(TF + (size_t)(g * 256 + tau * 16 + hh) * 384 + 256 + pg * 8) = w; }
            {
                const int row = u >> 1, hf = u & 1, p = row >> 1, c = row & 1; const float ar = AP[(128 + p) * 2], ai = AP[(128 + p) * 2 + 1]; float vals[8];
#pragma unroll
                for (int q = 0; q < 8; ++q) { const float br = BB[(p * 16 + hf * 8 + q) * 2], bi = BB[(p * 16 + hf * 8 + q) * 2 + 1]; vals[q] = c ? (ar * bi + ai * br) : (ar * br - ai * bi); }
                u32x4 w; w.x = cvt_pk_bf16(vals[0], vals[1]); w.y = cvt_pk_bf16(vals[2], vals[3]); w.z = cvt_pk_bf16(vals[4], vals[5]); w.w = cvt_pk_bf16(vals[6], vals[7]);
                *(u32x4*)(E + (size_t)(g * 256 + row) * 256 + tau * 16 + hf * 8) = w;
                *(u32x4*)(E + (size_t)(g * 256 + 128 + row) * 256 + tau * 16 + hf * 8) = (u32x4){0u, 0u, 0u, 0u}; }
        }
        __syncthreads();
        const int nblk = (16 - tau) * (tau > 0 ? 2 : 1);
        for (int j = tid; j < nblk * 32; j += 512) { const int blk = j >> 5, rh = j & 31, hrow = rh >> 1, hf = rh & 1;
            const int which = tau > 0 ? (blk & 1) : 0, bi = tau > 0 ? (blk >> 1) : blk;
            u32x4 w = {0u, 0u, 0u, 0u}; int row, col;
            if (which == 0) { row = (bi + tau) * 16 + hrow; col = bi * 16 + hf * 8; const float* kr = KT + hrow * 16 + hf * 8;
                w.x = cvt_pk_bf16(kr[0], kr[1]); w.y = cvt_pk_bf16(kr[2], kr[3]); w.z = cvt_pk_bf16(kr[4], kr[5]); w.w = cvt_pk_bf16(kr[6], kr[7]); }
            else { row = bi * 16 + hrow; col = (bi + tau) * 16 + hf * 8; }
            *(u32x4*)(TF + (size_t)(g * 256 + row) * 384 + col) = w; }
        __syncthreads();
        }
    }
}
__device__ __forceinline__ void s5_scan(const Params& P, int bid, int nb) {
    const int tid = otid(); if (tid < 64) {
    const float* __restrict__ XL = (const float*)(P.ws + WS_XLOC); bf16_t* __restrict__ S5Ap = (bf16_t*)(P.ws + WS_S5A);
    for (int gid = bid * 64 + tid; gid < 16384; gid += nb * 64) {
        const int p = gid & 63, g = (gid >> 6) & 63, b = gid >> 12;
        const float lr = P.lam_re[g * 64 + p], li = P.lam_im[g * 64 + p], dt = __expf(P.log_dt[g]);
        const float mg = __expf(16.0f * lr * dt), an = 16.0f * li * dt; const float ar = mg * __cosf(an), ai = mg * __sinf(an);
        float xr = 0.f, xi = 0.f; const size_t rowb = (size_t)g * 512 + b * 128;
        for (int n0 = 0; n0 < 128; n0 += 32) { f32x2 loc[32];
#pragma unroll
            for (int j = 0; j < 32; ++j) loc[j] = *(const f32x2*)(XL + (rowb + n0 + j) * 128 + 2 * p);
#pragma unroll
            for (int j = 0; j < 32; ++j) { *(unsigned*)(S5Ap + (rowb + n0 + j) * 384 + 256 + 2 * p) = cvt_pk_bf16(xr, xi);
                const float nr = ar * xr - ai * xi + loc[j].x, ni = ar * xi + ai * xr + loc[j].y; xr = nr; xi = ni; } }
    }
    }
}

#define XB_TMO      128
#define XB_XCNT(j)  (256  + 64 * (j))
#define XB_XSUB(j)  (1280 + 64 * (j))
#define XB_XGEN(j)  (2304 + 64 * (j))
#define XB_TOP      3328
#define XB_TOPGEN   3392
#define XCD_BAR_WORDS 3456
#define XB_SPIN_CAP (1u << 18)
__device__ __forceinline__ unsigned xb_ld(unsigned* p)              { return __hip_atomic_load(p, __ATOMIC_RELAXED, __HIP_MEMORY_SCOPE_AGENT); }
__device__ __forceinline__ unsigned xb_add(unsigned* p, unsigned v) { return __hip_atomic_fetch_add(p, v, __ATOMIC_RELAXED, __HIP_MEMORY_SCOPE_AGENT); }
__device__ __forceinline__ unsigned xb_xcc_id() { return (unsigned)__builtin_amdgcn_s_getreg((3 << 11) | 20) & 0xFu; }
#define XB_SPIN(cond, bar) do { unsigned _sp = 0; while (cond) { __builtin_amdgcn_s_sleep(1); \
    if ((++_sp & 255u) == 0u) { if (xb_ld(&(bar)[XB_TMO])) break; if (_sp > XB_SPIN_CAP) { atomicAdd(&(bar)[XB_TMO], 1u); break; } } } } while (0)
__device__ __forceinline__ void xcd_barrier_complete(unsigned* bar, unsigned x, unsigned& nloc, unsigned& nx) {
    const unsigned G = gridDim.x * gridDim.y * gridDim.z;
    unsigned sum, cnt, mine, sp = 0u;
    for (;;) {
        sum = 0u; cnt = 0u; mine = 0u;
#pragma unroll
        for (unsigned j = 0; j < 16; ++j) { const unsigned c = xb_ld(&bar[XB_XCNT(j)]); sum += c; cnt += (c > 0u) ? 1u : 0u; mine = (j == x) ? c : mine; }
        if (sum == G) break;
        __builtin_amdgcn_s_sleep(1);
        if ((++sp & 255u) == 0u) { if (xb_ld(&bar[XB_TMO])) break; if (sp > XB_SPIN_CAP) { atomicAdd(&bar[XB_TMO], 1u); break; } }
    }
    nloc = mine > 0u ? mine : 1u; nx = cnt > 0u ? cnt : 1u;
}
__device__ __forceinline__ void xcd_barrier(unsigned* bar, volatile LAS unsigned* st) {
    asm volatile("s_waitcnt vmcnt(0)" ::: "memory");
    __syncthreads();
    if (threadIdx.x == 0) {
        const unsigned x = xb_xcc_id();
        __builtin_amdgcn_s_waitcnt(0);
        unsigned nloc = st[0], nx = st[1];
        if (nloc == 0u) { xcd_barrier_complete(bar, x, nloc, nx); st[0] = nloc; st[1] = nx; }
        const unsigned old = xb_add(&bar[XB_XSUB(x)], 1u);
        const unsigned gen = old / nloc;
        if (old + 1u == (gen + 1u) * nloc) {
            __builtin_amdgcn_fence(__ATOMIC_RELEASE, "agent");
            asm volatile("s_waitcnt vmcnt(0)" ::: "memory");
            const unsigned og = xb_add(&bar[XB_TOP], 1u);
            const unsigned tg = og / nx;
            if (og + 1u == (tg + 1u) * nx) xb_add(&bar[XB_TOPGEN], 1u);
            else XB_SPIN(xb_ld(&bar[XB_TOPGEN]) == tg, bar);
            __builtin_amdgcn_fence(__ATOMIC_ACQUIRE, "agent");
            xb_add(&bar[XB_XGEN(x)], 1u);
            asm volatile("s_waitcnt vmcnt(0)" ::: "memory");
        } else {
            XB_SPIN(xb_ld(&bar[XB_XGEN(x)]) == gen, bar);
            __builtin_amdgcn_fence(__ATOMIC_ACQUIRE, "agent");
            asm volatile("s_waitcnt vmcnt(0)" ::: "memory");
        }
    }
    __syncthreads();
}

__global__ void __launch_bounds__(512, 2) fwd_megakernel(Params Pk) {
    extern __shared__ __attribute__((aligned(16))) unsigned char lds[];
    LAS unsigned char* glds = (LAS unsigned char*)lds;
    const int ph_lo = Pk.ph_lo, ph_hi = Pk.ph_hi;
    if (threadIdx.x == 0) { volatile LAS unsigned* st0 = (volatile LAS unsigned*)(glds + 155648); st0[0] = 0u; st0[1] = 0u;
        if (ph_hi - ph_lo > 1) (void)xb_add(&((unsigned*)(Pk.ws + WS_BAR))[XB_XCNT(xb_xcc_id())], 1u); }
    __syncthreads();
    if (ph_hi - ph_lo > 1 && blockIdx.x < 64) {
        const char* pc = (const char*)(__builtin_amdgcn_s_getpc() & ~63ull); unsigned accw = 0;
        for (int off = (int)threadIdx.x * 16; off < 208 * 1024; off += 512 * 16) { const u32x4 v = *(const u32x4*)(pc + off); accw += v.x ^ v.y ^ v.z ^ v.w; }
        asm volatile("" :: "v"(accw));
    }
#define WT_IN0 ((bf16_t*)(P.ws + WS_WT_IN0))
#define WT_OUT0 ((bf16_t*)(P.ws + WS_WT_OUT0))
#define WT_IN1 ((bf16_t*)(P.ws + WS_WT_IN1))
#define WT_GLU ((bf16_t*)(P.ws + WS_WT_GLU))
#define WT_OUT1 ((bf16_t*)(P.ws + WS_WT_OUT1))
#define HN ((bf16_t*)(P.ws + WS_HN))
#define Z ((bf16_t*)(P.ws + WS_Z))
#define YC ((bf16_t*)(P.ws + WS_YC))
#define S5A ((bf16_t*)(P.ws + WS_S5A))
#define S5B1 ((bf16_t*)(P.ws + WS_S5B1))
#define S5B2 ((bf16_t*)(P.ws + WS_S5B2))
#define XLOC ((float*)(P.ws + WS_XLOC))
#if defined(__HIP_DEVICE_COMPILE__)
#define PH_LOADP() Params P; { const __attribute__((address_space(4))) unsigned long long* s_ = (const __attribute__((address_space(4))) unsigned long long*)__builtin_amdgcn_kernarg_segment_ptr(); \
        asm volatile("" : "+s"(s_)); unsigned long long* dq_ = (unsigned long long*)&P; _Pragma("unroll") for (int i_ = 0; i_ < (int)(sizeof(Params) / 8); ++i_) dq_[i_] = s_[i_]; }
#else
#define PH_LOADP() const Params P = Pk;
#endif
#define PH_BEGIN(n) if (ph_lo <= (n) && (n) < ph_hi) for (int rep_ = 0; rep_ < ((((DBG_REP) >> (n)) & 1) ? 2 : 1); ++rep_) { \
        if ((n) > ph_lo || rep_) { if (ph_hi > 1000) cg::this_grid().sync(); else xcd_barrier((unsigned*)(Pk.ws + WS_BAR), (volatile LAS unsigned*)(glds + 155648)); } __syncthreads(); \
        int bid = blockIdx.x, nb = gridDim.x; asm volatile("" : "+s"(bid), "+s"(nb)); PH_LOADP()
#define PH_END }
    PH_BEGIN(0)
        rmsnorm_rows<true, 4>(P.x, P.norm_g, HN, bid, nb);
        convert_wt(P.ab_w_in, 2048, 7184, WT_IN0, 7424, 1, (float*)lds, bid, nb);
    PH_END
    PH_BEGIN(1)
        { pg8::StaticOrder S; S.init(NTOK, LDZ0, nb, bid); pg8::EpiZ0 E{Z};
          pg8::gemm_phase(glds, pg8::Gemm{HN, WT_IN0, 2048, 2048, 2048}, S, E); }
        { const int cb = nb == 256 ? bid - 160 : bid, cn = nb == 256 ? 96 : nb;
          if (cb >= 0) { __syncthreads();
            convert_wt(P.ab_w_out, 2048, 2048, WT_OUT0, 2048, 0, (float*)lds, cb, cn);
            convert_wt(P.cd_w_in, 2048, 6144, WT_IN1, 6144, 0, (float*)lds, cb, cn);
            convert_wt(P.w_glu, 1024, 1024, WT_GLU, 1024, 0, (float*)lds, cb, cn); } }
    PH_END
    PH_BEGIN(2)
        if (nb == 256) {
            const int xcd = bid & 7, slot = bid >> 3;
#define ATT_U(j) ((xcd + 8 * ((j) / 48)) * 48 + (j) % 48)
            AttnRegs R; attn_issue(Z, ATT_U(slot), R, otid());
            for (int j = slot; j < 192; j += 32) attn_unit(Z, (bf16_t*)P.out, (float*)((unsigned char*)P.out + DO_LSE), lds, ATT_U(j), (j + 32 < 192) ? ATT_U(j + 32) : -1, R);
#undef ATT_U
        } else { AttnRegs R; if (bid < 1536) attn_issue(Z, bid, R, otid());
          for (int u = bid; u < 1536; u += nb) attn_unit(Z, (bf16_t*)P.out, (float*)((unsigned char*)P.out + DO_LSE), lds, u, (u + nb < 1536) ? u + nb : -1, R); }
        { GlrRegs G; if (bid < 512) glr_issue<false, false>(P, bid, G, otid());
          for (int c = bid; c < 512; c += nb) glr_chunk<false, false>(P, lds, c, (c + nb < 512) ? c + nb : -1, G); }
    PH_END
    PH_BEGIN(3)
        if (otid() < 256) glr_scan<false>(P, bid, nb, 0, 256);
        else gate_l0(P, bid, nb, 4, 4);
        s5_gen(P, lds, bid, nb);
    PH_END
    PH_BEGIN(4)
        { GlrRegs G; if (bid < 512) glr_issue<false, true>(P, bid, G, otid());
          for (int c = bid; c < 512; c += nb) glr_chunk<false, true>(P, lds, c, (c + nb < 512) ? c + nb : -1, G); }
    PH_END
    PH_BEGIN(6)
        pg8::StaticOrder S; S.init(NTOK, DM, nb, bid);
        if (nb == 256) { pg8::EpiNorm<false> E{P.x, P.out, HN, P.norm_g + DM, (float*)(P.ws + WS_XS), (unsigned*)(P.ws + WS_CNT)};
            pg8::gemm_phase(glds, pg8::Gemm{(const bf16_t*)(P.ws + WS_OB), WT_OUT0, 2048, 2048, 2048}, S, E); }
        else { pg8::EpiRes E{P.x, P.out};
            pg8::gemm_phase(glds, pg8::Gemm{(const bf16_t*)(P.ws + WS_OB), WT_OUT0, 2048, 2048, 2048}, S, E); }
    PH_END
    if (gridDim.x != 256) {
    PH_BEGIN(7)
        rmsnorm_rows<true>(P.out, P.norm_g + DM, HN, bid, nb);
    PH_END
    }
    PH_BEGIN(8)
        pg8::StaticOrder S; S.init(NTOK, 6144, nb, bid); pg8::EpiZ1 E{Z, S5A};
        pg8::gemm_phase(glds, pg8::Gemm{HN, WT_IN1, 2048, 2048, 2048}, S, E);
    PH_END
    PH_BEGIN(9)
        { pg8::DiagOrder S{128, nb, bid}; pg8::EpiXloc E{XLOC};
          pg8::gemm_phase(glds, pg8::Gemm{S5A, S5B1, 384, 256, 256}, S, E); }
        { GlrRegs G; if (bid < 1024) glr_issue<true, false>(P, bid, G, otid());
          for (int c = bid; c < 1024; c += nb) glr_chunk<true, false>(P, lds, c, (c + nb < 1024) ? c + nb : -1, G); }
        __syncthreads();
        convert_wt(P.cd_w_out, 2048, 2048, WT_OUT1, 2048, 0, (float*)lds, bid, nb);
    PH_END
    PH_BEGIN(10)
        if (otid() < 64) s5_scan(P, bid, nb);
        else glr_scan<true>(P, bid, nb, 64, 448);
    PH_END
    PH_BEGIN(11)
        { pg8::DiagOrder S{128, nb, bid}; pg8::EpiS2 E{YC};
          pg8::gemm_phase(glds, pg8::Gemm{S5A, S5B2, 384, 384, 384}, S, E); }
        if (nb == 256) { const int c0 = bid < 128 ? bid : 128 + 2 * (bid - 128), cn = bid < 128 ? 1 : 2;
            GlrRegs G; glr_issue<true, true>(P, c0, G, otid());
            for (int c = c0; c < c0 + cn; ++c) glr_chunk<true, true>(P, lds, c, (c + 1 < c0 + cn) ? c + 1 : -1, G); }
        else { GlrRegs G; if (bid < 1024) glr_issue<true, true>(P, bid, G, otid());
            for (int c = bid; c < 1024; c += nb) glr_chunk<true, true>(P, lds, c, (c + nb < 1024) ? c + nb : -1, G); }
    PH_END
    PH_BEGIN(12)
        if (nb != 256 || bid < 128) { pg8::StaticOrder S; S.init(NTOK, 1024, nb == 256 ? 128 : nb, bid); pg8::EpiGlu E{YC, Z, P.b_glu, HN};
            pg8::gemm_phase(glds, pg8::Gemm{YC, WT_GLU, 1024, 1024, 1024}, S, E); }
        else { const int c0 = 384 + 5 * (bid - 128);
            GlrRegs G; glr_issue<true, true>(P, c0, G, otid());
            for (int c = c0; c < c0 + 5; ++c) glr_chunk<true, true>(P, lds, c, (c + 1 < c0 + 5) ? c + 1 : -1, G); }
    PH_END
    PH_BEGIN(13)
        pg8::StaticOrder S; S.init(NTOK, DM, nb, bid);
        if (nb == 256) { pg8::EpiNorm<true> E{P.out, P.out, nullptr, P.final_g, (float*)(P.ws + WS_XS + 262144), (unsigned*)(P.ws + WS_CNT + 8192)};
            pg8::gemm_phase(glds, pg8::Gemm{HN, WT_OUT1, 2048, 2048, 2048}, S, E); }
        else { pg8::EpiRes E{P.out, P.out};
            pg8::gemm_phase(glds, pg8::Gemm{HN, WT_OUT1, 2048, 2048, 2048}, S, E); }
    PH_END
    if (gridDim.x != 256) {
    PH_BEGIN(14)
        rmsnorm_rows<false>(P.out, P.final_g, P.out, bid, nb);
    PH_END
    }
}

extern "C" void kernel_launch(void* const* d_in, const int* in_sizes, int n_in, void* d_out, int out_size, void* d_ws, size_t ws_size, hipStream_t stream) {
    static int grid = 0;
    if (grid == 0) {
        if (n_in != 22 || out_size != NTOK * DM || ws_size < WS_TOP) { fprintf(stderr, "kernel_launch: unexpected shapes n_in %d out %d ws %zu\n", n_in, out_size, ws_size); grid = -1; return; }
        int dev = 0, cus = 0, per_cu = 0;
        (void)hipGetDevice(&dev); (void)hipDeviceGetAttribute(&cus, hipDeviceAttributeMultiprocessorCount, dev);
        if (hipFuncSetAttribute((const void*)fwd_megakernel, hipFuncAttributeMaxDynamicSharedMemorySize, LDS_BYTES) != hipSuccess) { fprintf(stderr, "kernel_launch: hipFuncSetAttribute failed\n"); grid = -1; return; }
        if (hipOccupancyMaxActiveBlocksPerMultiprocessor(&per_cu, (const void*)fwd_megakernel, 512, LDS_BYTES) != hipSuccess || per_cu < 1) { fprintf(stderr, "kernel_launch: occupancy query says %d\n", per_cu); per_cu = 1; }
        (void)hipGetLastError();
        if (cus <= 0) cus = 256;
        grid = cus;
    }
    if (grid < 0) return;
    Params p{};
    const float** pf = (const float**)&p;
    for (int i = 0; i < 22; ++i) pf[i] = (const float*)d_in[i];
    p.out = (float*)d_out; p.ws = (unsigned char*)d_ws;
#if N_LAUNCH_MODE == 1
    (void)hipMemsetAsync((unsigned char*)d_ws + WS_BAR, 0, 32768, stream);
    p.ph_lo = 0; p.ph_hi = NPHASE;
    void* args[] = {&p};
    hipError_t e = hipLaunchCooperativeKernel((const void*)fwd_megakernel, dim3(grid), dim3(512), args, LDS_BYTES, stream);
    if (e != hipSuccess) fprintf(stderr, "cooperative launch failed: %s (grid %d)\n", hipGetErrorString(e), grid);
#else
    for (int ph = 0; ph < NPHASE; ++ph) { p.ph_lo = ph; p.ph_hi = ph + 1; hipLaunchKernelGGL(fwd_megakernel, dim3(grid), dim3(512), LDS_BYTES, stream, p); }
#endif
}
```

```cpp
#include <hip/hip_runtime.h>
#include <hip/hip_cooperative_groups.h>
#include <cstdio>
#include <cstdint>
namespace cg = cooperative_groups;

#ifndef DBG_REP
#define DBG_REP 0
#endif
#ifndef N_LAUNCH_MODE
#define N_LAUNCH_MODE 1
#endif

typedef unsigned short bf16_t;
typedef short bf16x8 __attribute__((ext_vector_type(8)));
typedef short s16x4 __attribute__((ext_vector_type(4)));
typedef float f32x4 __attribute__((ext_vector_type(4)));
typedef float f32x2 __attribute__((ext_vector_type(2)));
typedef unsigned u32x4 __attribute__((ext_vector_type(4)));
typedef unsigned u32x2 __attribute__((ext_vector_type(2)));
#define LAS __attribute__((address_space(3)))

constexpr int NTOK = 8192, DM = 2048, SEQ = 2048;
constexpr int LDZ0 = 7424, LDZ1 = 5120;
constexpr int LDS_BYTES = 155648 + 16;
constexpr int NPHASE = 15;

constexpr size_t WS_WT_IN0 = 0;
constexpr size_t WS_WT_OUT0 = 30408704;
constexpr size_t WS_WT_IN1 = 38797312;
constexpr size_t WS_WT_GLU = 63963136;
constexpr size_t WS_WT_OUT1 = 66060288;
constexpr size_t WS_HN = 74448896;
constexpr size_t WS_Z = 108003328;
constexpr size_t WS_OB = 229638144;
constexpr size_t WS_YC = 246415360;
constexpr size_t WS_END = 263192576;
constexpr size_t WS_S5B1 = 0;
constexpr size_t WS_S5B2 = 8388608;
constexpr size_t WS_XLOC = 20971520;
constexpr size_t WS_S5A = WS_Z + 83886080;
constexpr size_t DO_LSE = 50331648;

struct Params {
    const float* x; const float* norm_g; const float* final_g; const float* ab_w_in; const float* gla_w_gate; const float* gla_b_gate;
    const float* gla_norm_g; const float* ab_w_out; const float* cd_w_in; const float* lam_re; const float* lam_im; const float* log_dt;
    const float* b_re; const float* b_im; const float* c_re; const float* c_im; const float* s5_d; const float* w_glu; const float* b_glu;
    const float* hgrn_gamma; const float* hgrn_norm_g; const float* cd_w_out;
    float* out; unsigned char* ws;
    int ph_lo, ph_hi;
};

__device__ __forceinline__ int otid() { int t = threadIdx.x; asm volatile("" : "+v"(t)); return t; }
__device__ __forceinline__ float bf2f(bf16_t b) { return __uint_as_float(((unsigned)b) << 16); }
typedef __bf16 bf16v2_t __attribute__((ext_vector_type(2)));
__device__ __forceinline__ unsigned cvt_pk_bf16(float lo, float hi) { bf16v2_t v = {(__bf16)lo, (__bf16)hi}; return __builtin_bit_cast(unsigned, v); }
__device__ __forceinline__ bf16_t f2bf(float f) { return (bf16_t)(cvt_pk_bf16(f, 0.f) & 0xffffu); }
__device__ __forceinline__ float lo_bf(unsigned w) { return __uint_as_float(w << 16); }
__device__ __forceinline__ float hi_bf(unsigned w) { return __uint_as_float(w & 0xffff0000u); }
__device__ __forceinline__ float sigmoidf_(float x) { return __builtin_amdgcn_rcpf(1.0f + __expf(-x)); }
__device__ __forceinline__ float siluf_(float x) { return x * sigmoidf_(x); }
__device__ __forceinline__ float logsigmoidf_(float x) { return fminf(x, 0.f) - __logf(1.0f + __expf(-fabsf(x))); }
typedef __bf16 bf16p2_t __attribute__((ext_vector_type(2)));
__device__ __forceinline__ float dot2bf(unsigned a, unsigned b, float c) { return __builtin_amdgcn_fdot2_f32_bf16(__builtin_bit_cast(bf16p2_t, a), __builtin_bit_cast(bf16p2_t, b), c, false); }
__device__ __forceinline__ f32x4 mfma16(bf16x8 a, bf16x8 b, f32x4 c) { return __builtin_amdgcn_mfma_f32_16x16x32_bf16(a, b, c, 0, 0, 0); }
__device__ __forceinline__ u32x2 pack4(f32x4 v) { u32x2 w; w.x = cvt_pk_bf16(v[0], v[1]); w.y = cvt_pk_bf16(v[2], v[3]); return w; }

__device__ __forceinline__ int map_col(int mode, int n, int nsrc) {
    if (mode == 1) { if (n < 5120) return n; if (n < 7168) return n + 16; if (n < 7184) return n - 2048; return -1; }
    return n < nsrc ? n : -1;
}
__device__ __forceinline__ void convert_wt(const float* __restrict__ W, int K, int Nsrc, bf16_t* __restrict__ WT, int Ndst, int mode, float* tile, int bid, int nb) {
    const int tid = otid(); const int tk = K / 64, tn = Ndst / 256, total = tk * tn;
    const int nn = tid & 63, kk = tid >> 6, n2 = tid >> 3, kq = tid & 7;
    float v[4][8];
#define CW_ISSUE(it_) do { const int n0_ = ((it_) / tk) * 256, k0_ = ((it_) % tk) * 64; _Pragma("unroll") for (int q = 0; q < 4; ++q) { const int sc = map_col(mode, n0_ + q * 64 + nn, Nsrc); \
        _Pragma("unroll") for (int i = 0; i < 8; ++i) v[q][i] = sc >= 0 ? __builtin_nontemporal_load(W + (size_t)(k0_ + kk * 8 + i) * Nsrc + sc) : 0.f; } } while (0)
    int it = bid; if (it < total) CW_ISSUE(it);
    for (; it < total; it += nb) {
        const int n0 = (it / tk) * 256, k0 = (it % tk) * 64;
#pragma unroll
        for (int q = 0; q < 4; ++q)
#pragma unroll
            for (int i = 0; i < 8; ++i) tile[q * 4160 + (kk * 8 + i) * 65 + nn] = v[q][i];
        if (it + nb < total) CW_ISSUE(it + nb);
        __syncthreads();
#pragma unroll
        for (int q = 0; q < 4; ++q) { float r[8];
#pragma unroll
            for (int j = 0; j < 8; ++j) r[j] = tile[q * 4160 + (kq * 8 + j) * 65 + n2];
            u32x4 w; w.x = cvt_pk_bf16(r[0], r[1]); w.y = cvt_pk_bf16(r[2], r[3]); w.z = cvt_pk_bf16(r[4], r[5]); w.w = cvt_pk_bf16(r[6], r[7]);
            *(u32x4*)(WT + (size_t)(n0 + q * 64 + n2) * K + k0 + kq * 8) = w; }
        __syncthreads();
    }
#undef CW_ISSUE
}
template <bool OUT_BF16, int RPT = 2>
__device__ __forceinline__ void rmsnorm_rows(const float* X, const float* __restrict__ g, void* outp, int bid, int nb) {
    const int tid_ = otid(); const int wid = tid_ >> 6, lane = tid_ & 63;
    const int step = nb * 8;
    for (int row = bid * 8 + wid; row < NTOK; row += RPT * step) {
        f32x4 v[RPT][8]; float ss[RPT]; int rr[RPT]; bool has[RPT];
#pragma unroll
        for (int r = 0; r < RPT; ++r) { rr[r] = row + r * step; has[r] = rr[r] < NTOK; if (!has[r]) rr[r] = row; }
#pragma unroll
        for (int r = 0; r < RPT; ++r)
#pragma unroll
            for (int i = 0; i < 8; ++i) v[r][i] = *(const f32x4*)(X + (size_t)rr[r] * DM + (i * 64 + lane) * 4);
#pragma unroll
        for (int r = 0; r < RPT; ++r) { float s = 0.f;
#pragma unroll
            for (int i = 0; i < 8; ++i) s += v[r][i][0] * v[r][i][0] + v[r][i][1] * v[r][i][1] + v[r][i][2] * v[r][i][2] + v[r][i][3] * v[r][i][3];
#pragma unroll
            for (int o = 32; o >= 1; o >>= 1) s += __shfl_xor(s, o);
            ss[r] = rsqrtf(s * (1.0f / DM) + 1e-6f); }
#pragma unroll
        for (int i = 0; i < 8; ++i) { const f32x4 gg = *(const f32x4*)(g + (i * 64 + lane) * 4);
#pragma unroll
            for (int r = 0; r < RPT; ++r) if (has[r]) {
                if (OUT_BF16) *(u32x2*)((bf16_t*)outp + (size_t)rr[r] * DM + (i * 64 + lane) * 4) = pack4(v[r][i] * ss[r] * gg);
                else *(f32x4*)((float*)outp + (size_t)rr[r] * DM + (i * 64 + lane) * 4) = v[r][i] * ss[r] * gg; } }
    }
}

namespace pg8 {
constexpr int BM = 256, BK = 64, HALF = 128, HTB = HALF * BK * 2, STAGE_BYTES = 8 * HTB, NXCD = 8, WGM = 4;
__device__ __forceinline__ int lds_byte(int r, int c) { const int st = (r >> 4) * 2 + (c >> 5), rr = r & 15, cc = c & 31, ob = rr * 64 + cc * 2; return st * 1024 + (ob ^ (((ob >> 9) & 1) << 5)); }
__device__ __forceinline__ void stage_rc(int b, int& R, int& C) { const int st = b / 1024, sb = b % 1024, swz = sb ^ (((sb >> 9) & 1) << 5); R = (st >> 1) * 16 + swz / 64; C = (st & 1) * 32 + (swz % 64) / 2; }
__device__ __forceinline__ int perm32(int rho) { const int n = rho >> 4, i = rho & 15; return 8 * (i >> 2) + 4 * n + (i & 3); }
struct Unit { int pm, pn; };
struct Gemm { const bf16_t* A; const bf16_t* Bt; int lda, ldb, K; };
struct StaticOrder {
    int nM, nN, nwg, G, c;
    __device__ void init(int M, int N, int G_, int c_) { nM = M / BM; nN = N / BM; nwg = nM * nN; G = G_; c = c_; }
    __device__ bool next(int i, Unit& u) const {
        const long L = (long)i * G + c; if (c < 0 || L >= nwg) return false;
        int wgid = (int)L; { const int q = nwg / NXCD, r = nwg % NXCD, xcd = wgid % NXCD, off = wgid / NXCD; wgid = (xcd < r ? xcd * (q + 1) : r * (q + 1) + (xcd - r) * q) + off; }
        const int nig = WGM * nN, gid = wgid / nig, fm = gid * WGM, gsz = (nM - fm) < WGM ? (nM - fm) : WGM;
        u.pm = fm + ((wgid % nig) % gsz); u.pn = (wgid % nig) / gsz; return true;
    }
};
struct DiagOrder {
    int n, G, c;
    __device__ bool next(int i, Unit& u) const { const int L = i * G + c; if (c < 0 || L >= n) return false; u.pm = L; u.pn = L >> 1; return true; }
};

struct EpiZ0 {
    static constexpr bool PERM = true, AFTER_DRAIN = false, ACC_INIT = false;
    bf16_t* O;
    __device__ __forceinline__ void operator()(const f32x4 (&acc)[2][2][4][2], const Unit& u, int wr, int wc, int fr, int fq) const {
        const int row0 = u.pm * BM + wr * 64 + fr, col0 = u.pn * BM + wc * 32 + 8 * fq;
#pragma unroll
        for (int ai = 0; ai < 2; ++ai)
#pragma unroll
            for (int m = 0; m < 4; ++m) { bf16_t* rowp = O + (size_t)(row0 + ai * HALF + m * 16) * LDZ0 + col0;
#pragma unroll
                for (int bj = 0; bj < 2; ++bj) { const f32x4 v0 = acc[ai][bj][m][0], v1 = acc[ai][bj][m][1];
                    u32x4 w; w.x = cvt_pk_bf16(v0[0], v0[1]); w.y = cvt_pk_bf16(v0[2], v0[3]); w.z = cvt_pk_bf16(v1[0], v1[1]); w.w = cvt_pk_bf16(v1[2], v1[3]);
                    *(u32x4*)(rowp + bj * HALF) = w; } }
    }
};
struct EpiZ1 {
    static constexpr bool PERM = true, AFTER_DRAIN = false, ACC_INIT = false;
    bf16_t* Z1; bf16_t* S5A;
    __device__ __forceinline__ void operator()(const f32x4 (&acc)[2][2][4][2], const Unit& u, int wr, int wc, int fr, int fq) const {
        const int row0 = u.pm * BM + wr * 64 + fr, col0 = u.pn * BM + wc * 32 + 8 * fq;
#pragma unroll
        for (int ai = 0; ai < 2; ++ai)
#pragma unroll
            for (int m = 0; m < 4; ++m) { const int t = row0 + ai * HALF + m * 16;
#pragma unroll
                for (int bj = 0; bj < 2; ++bj) { const f32x4 v0 = acc[ai][bj][m][0], v1 = acc[ai][bj][m][1];
                    u32x4 w; w.x = cvt_pk_bf16(v0[0], v0[1]); w.y = cvt_pk_bf16(v0[2], v0[3]); w.z = cvt_pk_bf16(v1[0], v1[1]); w.w = cvt_pk_bf16(v1[2], v1[3]);
                    const int c = col0 + bj * HALF;
                    if (u.pn < 4) *(u32x4*)(S5A + ((size_t)((c >> 4) * 512 + (t >> 4))) * 384 + (t & 15) * 16 + (c & 15)) = w;
                    else *(u32x4*)(Z1 + (size_t)t * LDZ1 + (c - 1024)) = w; } }
    }
};
struct EpiRes {
    static constexpr bool PERM = false, AFTER_DRAIN = false, ACC_INIT = false;
    const float* base; float* out;
    __device__ __forceinline__ void operator()(const f32x4 (&acc)[2][2][4][2], const Unit& u, int wr, int wc, int fr, int fq) const {
        const int row0 = u.pm * BM + wr * 64 + fr, col0 = u.pn * BM + wc * 32 + 4 * fq;
#pragma unroll
        for (int ai = 0; ai < 2; ++ai)
#pragma unroll
            for (int m = 0; m < 4; ++m) { const size_t off = (size_t)(row0 + ai * HALF + m * 16) * DM + col0;
#pragma unroll
                for (int bj = 0; bj < 2; ++bj)
#pragma unroll
                    for (int n = 0; n < 2; ++n) { const f32x4 bs = *(const f32x4*)(base + off + bj * HALF + n * 16); *(f32x4*)(out + off + bj * HALF + n * 16) = bs + acc[ai][bj][m][n]; } }
    }
};
struct EpiXloc {
    static constexpr bool PERM = false, AFTER_DRAIN = false, ACC_INIT = false;
    float* X;
    __device__ __forceinline__ void operator()(const f32x4 (&acc)[2][2][4][2], const Unit& u, int wr, int wc, int fr, int fq) const {
        const int row0 = u.pm * BM + wr * 64 + fr, col0 = wc * 32 + 4 * fq;
#pragma unroll
        for (int ai = 0; ai < 2; ++ai)
#pragma unroll
            for (int m = 0; m < 4; ++m) { float* rowp = X + (size_t)(row0 + ai * HALF + m * 16) * 128 + col0;
#pragma unroll
                for (int n = 0; n < 2; ++n) *(f32x4*)(rowp + n * 16) = acc[ai][0][m][n]; }
    }
};
__device__ __forceinline__ float gelu_tanh(float y) { const float z = 1.5957691216057308f * (y + 0.044715f * y * y * y); return y / (1.0f + __expf(-z)); }
struct EpiS2 {
    static constexpr bool PERM = true, AFTER_DRAIN = false, ACC_INIT = false;
    bf16_t* YC;
    __device__ __forceinline__ void operator()(const f32x4 (&acc)[2][2][4][2], const Unit& u, int wr, int wc, int fr, int fq) const {
        const int row0 = u.pm * BM + wr * 64 + fr, col0 = wc * 32 + 8 * fq;
#pragma unroll
        for (int ai = 0; ai < 2; ++ai)
#pragma unroll
            for (int m = 0; m < 4; ++m) { const int R = row0 + ai * HALF + m * 16, g = R >> 9, ch = R & 511;
#pragma unroll
                for (int bj = 0; bj < 2; ++bj) { const f32x4 v0 = acc[ai][bj][m][0], v1 = acc[ai][bj][m][1];
                    u32x4 w; w.x = cvt_pk_bf16(gelu_tanh(v0[0]), gelu_tanh(v0[1])); w.y = cvt_pk_bf16(gelu_tanh(v0[2]), gelu_tanh(v0[3]));
                    w.z = cvt_pk_bf16(gelu_tanh(v1[0]), gelu_tanh(v1[1])); w.w = cvt_pk_bf16(gelu_tanh(v1[2]), gelu_tanh(v1[3]));
                    const int c = col0 + bj * HALF;
                    *(u32x4*)(YC + (size_t)(ch * 16 + (c >> 4)) * 1024 + g * 16 + (c & 15)) = w; } }
    }
};
struct EpiGlu {
    static constexpr bool PERM = true, AFTER_DRAIN = false, ACC_INIT = false;
    const bf16_t* YC; const bf16_t* Z1; const float* bglu; bf16_t* Y;
    static __device__ __forceinline__ float sg(float y, float v, float g) { return y * g * __builtin_amdgcn_rcpf((1.0f + __expf(-v)) * (1.0f + __expf(-g))); }
    __device__ __forceinline__ void operator()(const f32x4 (&acc)[2][2][4][2], const Unit& u, int wr, int wc, int fr, int fq) const {
        const int row0 = u.pm * BM + wr * 64 + fr, col0 = u.pn * BM + wc * 32 + 8 * fq;
        f32x4 bb[2][2];
#pragma unroll
        for (int bj = 0; bj < 2; ++bj) { bb[bj][0] = *(const f32x4*)(bglu + col0 + bj * HALF); bb[bj][1] = *(const f32x4*)(bglu + col0 + bj * HALF + 4); }
#pragma unroll
        for (int ai = 0; ai < 2; ++ai)
#pragma unroll
            for (int m = 0; m < 4; ++m) { const int t = row0 + ai * HALF + m * 16;
#pragma unroll
                for (int bj = 0; bj < 2; ++bj) { const int c = col0 + bj * HALF;
                    const u32x4 yv = *(const u32x4*)(YC + (size_t)t * 1024 + c); const u32x4 gv = *(const u32x4*)(Z1 + (size_t)t * LDZ1 + 3072 + c);
                    const f32x4 v0 = acc[ai][bj][m][0] + bb[bj][0], v1 = acc[ai][bj][m][1] + bb[bj][1];
                    float r[8];
                    r[0] = sg(lo_bf(yv.x), v0[0], lo_bf(gv.x)); r[1] = sg(hi_bf(yv.x), v0[1], hi_bf(gv.x));
                    r[2] = sg(lo_bf(yv.y), v0[2], lo_bf(gv.y)); r[3] = sg(hi_bf(yv.y), v0[3], hi_bf(gv.y));
                    r[4] = sg(lo_bf(yv.z), v1[0], lo_bf(gv.z)); r[5] = sg(hi_bf(yv.z), v1[1], hi_bf(gv.z));
                    r[6] = sg(lo_bf(yv.w), v1[2], lo_bf(gv.w)); r[7] = sg(hi_bf(yv.w), v1[3], hi_bf(gv.w));
                    u32x4 w; w.x = cvt_pk_bf16(r[0], r[1]); w.y = cvt_pk_bf16(r[2], r[3]); w.z = cvt_pk_bf16(r[4], r[5]); w.w = cvt_pk_bf16(r[6], r[7]);
                    *(u32x4*)(Y + (size_t)t * DM + c) = w; } }
    }
};
template <bool FINAL> struct EpiNorm {
    static constexpr bool PERM = false, AFTER_DRAIN = true, ACC_INIT = true;
    const float* base; float* hout; bf16_t* nout; const float* g; float* xs; unsigned* cnt;
    __device__ __forceinline__ void init(f32x4 (&acc)[2][2][4][2], const Unit& u, int wr, int wc, int fr, int fq) const {
        const int row0 = u.pm * BM + wr * 64 + fr, col0 = u.pn * BM + wc * 32 + 4 * fq;
#pragma unroll
        for (int ai = 0; ai < 2; ++ai)
#pragma unroll
            for (int m = 0; m < 4; ++m) { const size_t off = (size_t)(row0 + ai * HALF + m * 16) * DM + col0;
#pragma unroll
                for (int bj = 0; bj < 2; ++bj)
#pragma unroll
                    for (int n = 0; n < 2; ++n) acc[ai][bj][m][n] = *(const f32x4*)(base + off + bj * HALF + n * 16); }
    }
    __device__ __forceinline__ void operator()(const f32x4 (&)[2][2][4][2], const Unit&, int, int, int, int) const {}
    __device__ __forceinline__ void fused(f32x4 (&acc)[2][2][4][2], const Unit& u, int wr, int wc, int fr, int fq, LAS unsigned char* lds, int wid, int lane) const {
        LAS float* PT = (LAS float*)lds;
        LAS float* ST = (LAS float*)(lds + 4096);
        const int row0 = u.pm * BM + wr * 64 + fr, col0 = u.pn * BM + wc * 32 + 4 * fq;
#pragma unroll
        for (int ai = 0; ai < 2; ++ai)
#pragma unroll
            for (int m = 0; m < 4; ++m) { const size_t off = (size_t)(row0 + ai * HALF + m * 16) * DM + col0; float s = 0.f;
#pragma unroll
                for (int bj = 0; bj < 2; ++bj)
#pragma unroll
                    for (int n = 0; n < 2; ++n) { const f32x4 h = acc[ai][bj][m][n];
                        s += h[0] * h[0] + h[1] * h[1] + h[2] * h[2] + h[3] * h[3]; }
                s += __shfl_xor(s, 16); s += __shfl_xor(s, 32);
                if (fq == 0) PT[(ai * HALF + wr * 64 + m * 16 + fr) * 4 + wc] = s; }
        __syncthreads();
        const int row = wid * 32 + (lane & 31);
        if (lane < 32) { const float tot = (PT[row * 4] + PT[row * 4 + 1]) + (PT[row * 4 + 2] + PT[row * 4 + 3]);
            __hip_atomic_store(xs + ((size_t)(u.pm * BM + row)) * 8 + u.pn, tot, __ATOMIC_RELAXED, __HIP_MEMORY_SCOPE_AGENT); }
        asm volatile("s_waitcnt vmcnt(0)" ::: "memory");
        if (lane == 0) __hip_atomic_fetch_add(cnt + 64 * u.pm, 1u, __ATOMIC_RELAXED, __HIP_MEMORY_SCOPE_AGENT);
        if (wid == 0) { unsigned sp = 0;
            while ((unsigned)__builtin_amdgcn_readfirstlane(__hip_atomic_load(cnt + 64 * u.pm, __ATOMIC_RELAXED, __HIP_MEMORY_SCOPE_AGENT)) < 64u) { __builtin_amdgcn_s_sleep(2); if (++sp > (1u << 22)) break; }
            __builtin_amdgcn_fence(__ATOMIC_ACQUIRE, "agent");
            asm volatile("s_waitcnt vmcnt(0)" ::: "memory"); }
        __syncthreads();
        if (lane < 32) { const float* sl = xs + ((size_t)(u.pm * BM + row)) * 8; float tot = 0.f;
#pragma unroll
            for (int t = 0; t < 8; ++t) tot += __hip_atomic_load(sl + t, __ATOMIC_RELAXED, __HIP_MEMORY_SCOPE_AGENT);
            ST[row] = rsqrtf(tot * (1.0f / DM) + 1e-6f); }
        __syncthreads();
        f32x4 ggv[2][2];
#pragma unroll
        for (int bj = 0; bj < 2; ++bj)
#pragma unroll
            for (int n = 0; n < 2; ++n) ggv[bj][n] = *(const f32x4*)(g + col0 + bj * HALF + n * 16);
#pragma unroll
        for (int ai = 0; ai < 2; ++ai)
#pragma unroll
            for (int m = 0; m < 4; ++m) { const int r = ai * HALF + wr * 64 + m * 16 + fr; const float rinv = ST[r]; const size_t off = (size_t)(u.pm * BM + r) * DM + col0;
#pragma unroll
                for (int bj = 0; bj < 2; ++bj)
#pragma unroll
                    for (int n = 0; n < 2; ++n) { const f32x4 gg = ggv[bj][n]; const f32x4 h = acc[ai][bj][m][n];
                        if (FINAL) *(f32x4*)(hout + off + bj * HALF + n * 16) = h * rinv * gg;
                        else { *(f32x4*)(hout + off + bj * HALF + n * 16) = h; *(u32x2*)(nout + off + bj * HALF + n * 16) = pack4(h * rinv * gg); } }
                }
    }
};

template <class Epi, class Sched>
__device__ __forceinline__ void gemm_phase(LAS unsigned char* lds, const Gemm g, const Sched& S, const Epi& E) {
    const int tid = otid(), wid = __builtin_amdgcn_readfirstlane(tid >> 6), lane = tid & 63, wr = wid >> 2, wc = wid & 3, fr = lane & 15, fq = lane >> 4;
    const int K = g.K, nt = K / BK;
    unsigned voffA[2], voffB[2];
#pragma unroll
    for (int i = 0; i < 2; ++i) { int R, C; stage_rc(tid * 16 + i * 8192, R, C); const int Rb = Epi::PERM ? ((R & ~31) + perm32(R & 31)) : R;
        voffA[i] = (unsigned)(R * g.lda + C) * 2u; voffB[i] = (unsigned)(Rb * g.ldb + C) * 2u; }
    const size_t kstep = (size_t)(BK * 2);
    const size_t hstepA = (size_t)HALF * g.lda * 2, hstepB = (size_t)HALF * g.ldb * 2;
    const size_t tstepA = 2 * hstepA, tstepB = 2 * hstepB;
    const unsigned ldsw = (unsigned)wid * 1024u;
    const int aoff = lds_byte(wr * 64 + fr, fq * 8), boff = lds_byte(wc * 32 + fr, fq * 8);
#define PG8_SA(b, h) (((b) * 2 + (h)) * HTB)
#define PG8_SB(b, h) ((4 + (b) * 2 + (h)) * HTB)
#define PG8_STAGE(bufoff, gbase, voff) do { _Pragma("unroll") for (int _i = 0; _i < 2; ++_i) \
        __builtin_amdgcn_global_load_lds((const unsigned*)((const char*)(gbase) + (voff)[_i]), (LAS unsigned*)(lds + (bufoff) + ldsw + _i * 8192), 16, 0, 0); } while (0)
#define PG8_LDA(dst, b, h) do { _Pragma("unroll") for (int m = 0; m < 4; ++m) _Pragma("unroll") for (int k = 0; k < 2; ++k) dst[m][k] = *(const LAS bf16x8*)(lds + PG8_SA(b, h) + aoff + m * 2048 + k * 1024); } while (0)
#define PG8_LDB(dst, b, h) do { _Pragma("unroll") for (int n = 0; n < 2; ++n) _Pragma("unroll") for (int k = 0; k < 2; ++k) dst[n][k] = *(const LAS bf16x8*)(lds + PG8_SB(b, h) + boff + n * 2048 + k * 1024); } while (0)
#define PG8_MMA(ai, bj, At, Bt) do { __builtin_amdgcn_s_setprio(1); _Pragma("unroll") for (int m = 0; m < 4; ++m) _Pragma("unroll") for (int n = 0; n < 2; ++n) _Pragma("unroll") for (int k = 0; k < 2; ++k) \
        acc[ai][bj][m][n] = __builtin_amdgcn_mfma_f32_16x16x32_bf16(Bt[n][k], At[m][k], acc[ai][bj][m][n], 0, 0, 0); __builtin_amdgcn_s_setprio(0); } while (0)
#define PG8_WAIT_V(n) asm volatile("s_waitcnt vmcnt(" #n ")" ::: "memory")
#define PG8_WAIT_L(n) asm volatile("s_waitcnt lgkmcnt(" #n ")" ::: "memory")
#define PG8_BAR __builtin_amdgcn_s_barrier()
#define PG8_SCHED __builtin_amdgcn_sched_barrier(0)
    Unit cur, nxt; int ui = 0;
    if (!S.next(0, cur)) return;
    f32x4 acc[2][2][4][2];
    if constexpr (Epi::ACC_INIT) E.init(acc, cur, wr, wc, fr, fq);
    else {
#pragma unroll
    for (int a = 0; a < 2; ++a)
#pragma unroll
        for (int b = 0; b < 2; ++b)
#pragma unroll
            for (int m = 0; m < 4; ++m)
#pragma unroll
                for (int n = 0; n < 2; ++n) acc[a][b][m][n] = (f32x4){0.f, 0.f, 0.f, 0.f};
    }
    bf16x8 At[4][2], B0[2][2], B1[2][2];
    const char* cA = (const char*)g.A + (size_t)cur.pm * tstepA; const char* cB = (const char*)g.Bt + (size_t)cur.pn * tstepB;
    PG8_STAGE(PG8_SB(0, 0), cB, voffB); PG8_STAGE(PG8_SA(0, 0), cA, voffA); PG8_STAGE(PG8_SB(0, 1), cB + hstepB, voffB); PG8_STAGE(PG8_SA(0, 1), cA + hstepA, voffA);
    if (wr == 1) PG8_BAR;
    PG8_WAIT_V(4); PG8_BAR;
    PG8_STAGE(PG8_SB(1, 0), cB + kstep, voffB); PG8_STAGE(PG8_SA(1, 0), cA + kstep, voffA); PG8_STAGE(PG8_SB(1, 1), cB + hstepB + kstep, voffB);
    PG8_WAIT_V(6); PG8_BAR;
    for (;;) {
        const bool has_next = S.next(ui + 1, nxt);
        const char* nA = has_next ? (const char*)g.A + (size_t)nxt.pm * tstepA : cA; const char* nB = has_next ? (const char*)g.Bt + (size_t)nxt.pn * tstepB : cB;
        for (int t = 0; t < nt; t += 2) {
            const bool last = (t == nt - 2);
            const char* a1 = cA + (size_t)(t + 1) * kstep;
            const char* a2 = last ? nA : cA + (size_t)(t + 2) * kstep; const char* b2 = last ? nB : cB + (size_t)(t + 2) * kstep;
            const char* a3 = a2 + kstep; const char* b3 = b2 + kstep;
            PG8_LDB(B0, 0, 0); PG8_SCHED; PG8_LDA(At, 0, 0); PG8_STAGE(PG8_SA(1, 1), a1 + hstepA, voffA);
            PG8_WAIT_L(8); PG8_BAR; PG8_WAIT_L(0); PG8_MMA(0, 0, At, B0); PG8_BAR; PG8_SCHED;
            PG8_LDB(B1, 0, 1); PG8_STAGE(PG8_SB(0, 0), b2, voffB);
            PG8_BAR; PG8_WAIT_L(0); PG8_MMA(0, 1, At, B1); PG8_BAR;
            PG8_LDA(At, 0, 1); PG8_STAGE(PG8_SA(0, 0), a2, voffA);
            PG8_BAR; PG8_WAIT_L(0); PG8_MMA(1, 0, At, B0); PG8_BAR; PG8_SCHED;
            PG8_STAGE(PG8_SB(0, 1), b2 + hstepB, voffB);
            PG8_WAIT_V(6); PG8_BAR; PG8_MMA(1, 1, At, B1); PG8_BAR;
            PG8_LDB(B0, 1, 0); PG8_SCHED; PG8_LDA(At, 1, 0); PG8_STAGE(PG8_SA(0, 1), a2 + hstepA, voffA);
            PG8_WAIT_L(8); PG8_BAR; PG8_WAIT_L(0); PG8_MMA(0, 0, At, B0); PG8_BAR; PG8_SCHED;
            PG8_LDB(B1, 1, 1); PG8_STAGE(PG8_SB(1, 0), b3, voffB);
            PG8_BAR; PG8_WAIT_L(0); PG8_MMA(0, 1, At, B1); PG8_BAR;
            PG8_LDA(At, 1, 1); PG8_STAGE(PG8_SA(1, 0), a3, voffA);
            PG8_BAR; PG8_WAIT_L(0); PG8_MMA(1, 0, At, B0); PG8_BAR; PG8_SCHED;
            PG8_STAGE(PG8_SB(1, 1), b3 + hstepB, voffB);
            PG8_WAIT_V(6); PG8_BAR; PG8_MMA(1, 1, At, B1); PG8_BAR;
        }
        if constexpr (!Epi::AFTER_DRAIN) E(acc, cur, wr, wc, fr, fq);
        if (!has_next) break;
#pragma unroll
        for (int a = 0; a < 2; ++a)
#pragma unroll
            for (int b = 0; b < 2; ++b)
#pragma unroll
                for (int m = 0; m < 4; ++m)
#pragma unroll
                    for (int n = 0; n < 2; ++n) acc[a][b][m][n] = (f32x4){0.f, 0.f, 0.f, 0.f};
        cur = nxt; cA = nA; cB = nB; ++ui;
    }
    PG8_WAIT_V(0);
    if (wr == 0) PG8_BAR;
    PG8_BAR;
    if constexpr (Epi::AFTER_DRAIN) E.fused(acc, cur, wr, wc, fr, fq, lds, wid, lane);
#undef PG8_SA
#undef PG8_SB
#undef PG8_STAGE
#undef PG8_LDA
#undef PG8_LDB
#undef PG8_MMA
#undef PG8_WAIT_V
#undef PG8_WAIT_L
#undef PG8_BAR
#undef PG8_SCHED
}
}

constexpr int AT_KSTR = 272, AT_VSTR = 288, AT_VOFF = 256 * AT_KSTR;
struct AttnRegs { u32x4 k[8], v[8]; bf16x8 q[4]; };
__device__ __forceinline__ void attn_decode(int u, int& p, int& b, int& h, int& r, int& blk) {
    const int bh = u / 48, w = u % 48; b = bh >> 3; h = bh & 7;
    if (w < 16) { p = 0; r = 0; blk = w; } else if (w < 32) { p = 1; r = (w - 16) >> 2; blk = (w - 16) & 3; } else { p = 2; r = w - 32; blk = 0; }
}
__device__ __forceinline__ void attn_issue(const bf16_t* __restrict__ Z, int u, AttnRegs& R, int tid) {
    int p, b, h, r, nb; attn_decode(u, p, b, h, r, nb);
    const int d = (p == 0) ? 1 : (p == 1 ? 4 : 16), kidx0 = nb * 128 - 128;
    const int wid = tid >> 6, lane = tid & 63, fr = lane & 15, fq = lane >> 4;
#pragma unroll
    for (int i = 0; i < 8; ++i) { const int id = tid + 512 * i, key = id >> 4, ch = id & 15, kidx = kidx0 + key;
        R.k[i] = (u32x4){0u, 0u, 0u, 0u}; R.v[i] = (u32x4){0u, 0u, 0u, 0u};
        if (kidx >= 0) { const bf16_t* rowp = Z + (size_t)(b * SEQ + kidx * d + r) * LDZ0; R.k[i] = *(const u32x4*)(rowp + 1024 + h * 128 + ch * 8); R.v[i] = *(const u32x4*)(rowp + 2048 + h * 128 + ch * 8); } }
    const int qi = wid * 16 + fr, qpos = (nb * 128 + qi) * d + r;
    const bf16_t* qrow = Z + (size_t)(b * SEQ + qpos) * LDZ0 + h * 128;
#pragma unroll
    for (int s = 0; s < 4; ++s) R.q[s] = *(const bf16x8*)(qrow + 32 * s + 8 * fq);
}
__device__ __forceinline__ void attn_unit(const bf16_t* __restrict__ Z, bf16_t* __restrict__ OP, float* __restrict__ LSE, unsigned char* lds, int u, int unext, AttnRegs& R) {
    const int tid = otid(), wid = tid >> 6, lane = tid & 63, fr = lane & 15, fq = lane >> 4;
    int p, b, h, r, nb; attn_decode(u, p, b, h, r, nb);
    const int d = (p == 0) ? 1 : (p == 1 ? 4 : 16);
    const int kidx0 = nb * 128 - 128;
    __syncthreads();
#pragma unroll
    for (int i = 0; i < 8; ++i) { const int id = tid + 512 * i, key = id >> 4, ch = id & 15;
        *(u32x4*)(lds + key * AT_KSTR + ch * 16) = R.k[i]; *(u32x4*)(lds + AT_VOFF + key * AT_VSTR + ch * 16) = R.v[i]; }
    if (tid < 288) *(u32x4*)(lds + AT_VOFF + 256 * AT_VSTR + tid * 16) = (u32x4){0u, 0u, 0u, 0u};
    const int qi = wid * 16 + fr, qpos = (nb * 128 + qi) * d + r;
    bf16x8 qf[4];
#pragma unroll
    for (int s = 0; s < 4; ++s) qf[s] = R.q[s];
    if (unext >= 0) attn_issue(Z, unext, R, tid);
    __syncthreads();
    f32x4 sc[10];
    const int widu = __builtin_amdgcn_readfirstlane(wid);
    const bool firstblk = (nb == 0);
#pragma unroll
    for (int kt = 0; kt < 9; ++kt) { sc[kt] = (f32x4){0.f, 0.f, 0.f, 0.f};
        if (!firstblk || widu + kt >= 8) {
#pragma unroll
        for (int s = 0; s < 4; ++s) { const bf16x8 kf = *(const bf16x8*)(lds + (16 * (wid + kt) + fr) * AT_KSTR + (32 * s + 8 * fq) * 2); sc[kt] = mfma16(kf, qf[s], sc[kt]); } } }
    sc[9] = (f32x4){0.f, 0.f, 0.f, 0.f};
    const float NEG = -__builtin_inff();
    float m = -1e30f;
#pragma unroll
    for (int kt = 0; kt < 9; ++kt) { const bool tile_ok = (nb != 0) || (wid + kt >= 8);
#pragma unroll
        for (int ri = 0; ri < 4; ++ri) { bool valid = tile_ok;
            if (kt == 0) valid = valid && (4 * fq + ri >= fr);
            if (kt == 8) valid = valid && (4 * fq + ri <= fr);
            const float s = valid ? sc[kt][ri] : NEG; sc[kt][ri] = s; m = fmaxf(m, s); } }
    m = fmaxf(m, __shfl_xor(m, 16)); m = fmaxf(m, __shfl_xor(m, 32));
    constexpr float C2 = 0.08838834764831845f * 1.4426950408889634f;
    const float mC = -m * C2;
    float l = 0.f;
#pragma unroll
    for (int kt = 0; kt < 9; ++kt)
#pragma unroll
        for (int ri = 0; ri < 4; ++ri) { const float e = __builtin_amdgcn_exp2f(fmaf(sc[kt][ri], C2, mC)); sc[kt][ri] = e; l += e; }
    l += __shfl_xor(l, 16); l += __shfl_xor(l, 32);
    f32x4 o[8];
#pragma unroll
    for (int et = 0; et < 8; ++et) o[et] = (f32x4){0.f, 0.f, 0.f, 0.f};
    const int q4 = fr >> 2, p4 = fr & 3;
    const unsigned char* vbase = lds + AT_VOFF + (16 * wid + 4 * fq + q4) * AT_VSTR + 8 * p4;
#pragma unroll
    for (int st = 0; st < 5; ++st) {
        if (firstblk && widu + 2 * st + 1 < 8) continue;
        const u32x2 plo = pack4(sc[2 * st]), phi = pack4(sc[2 * st + 1]);
        u32x4 pw = {plo.x, plo.y, phi.x, phi.y}; const bf16x8 pb = *reinterpret_cast<bf16x8*>(&pw);
#pragma unroll
        for (int et = 0; et < 8; ++et) {
            const s16x4 lo = __builtin_amdgcn_ds_read_tr16_b64_v4i16((LAS s16x4*)(vbase + (32 * st) * AT_VSTR + et * 32));
            const s16x4 hi = __builtin_amdgcn_ds_read_tr16_b64_v4i16((LAS s16x4*)(vbase + (32 * st + 16) * AT_VSTR + et * 32));
            const bf16x8 va = {lo[0], lo[1], lo[2], lo[3], hi[0], hi[1], hi[2], hi[3]};
            o[et] = mfma16(va, pb, o[et]); }
    }
    const float inv = 1.0f / l; const size_t token = (size_t)b * SEQ + qpos;
    bf16_t* orow = OP + (size_t)p * NTOK * 1024 + token * 1024 + h * 128 + 4 * fq;
#pragma unroll
    for (int et = 0; et < 8; ++et) *(u32x2*)(orow + 16 * et) = pack4(o[et] * inv);
    if (fq == 0) LSE[((size_t)p * NTOK + token) * 8 + h] = m * 0.08838834764831845f + __logf(l);
}

template <bool HG> __device__ __forceinline__ bf16_t* us_chunk(unsigned char* ws, int c) {
    if (!HG) return (bf16_t*)(ws + WS_HN) + (size_t)c * 256 * 128;
    return (c < 512) ? (bf16_t*)(ws + WS_WT_IN1) + (size_t)c * 128 * 128 : (bf16_t*)(ws + WS_OB) + (size_t)(c - 512) * 128 * 128;
}
constexpr size_t WS_DV = WS_END, WS_EMV = WS_END + 524288, WS_BAR = WS_END + 1048576, WS_CNT = WS_BAR + 16384, WS_XS = WS_BAR + 32768, WS_TOP = WS_XS + 524288;
struct GlrRegs { u32x4 k[2], q[2], v[4], gl, s[8]; float wg[16], bg, g0, g1; };
template <bool HG, bool PC>
__device__ __forceinline__ void glr_issue(const Params& P, int cc, GlrRegs& R, int tid) {
    constexpr int V = HG ? 128 : 256, VCH = V / 8;
    const int bh = cc >> 5, n = cc & 31;
    const int b = HG ? (bh >> 3) : (bh >> 2), h = HG ? (bh & 7) : (bh & 3);
    const bf16_t* Zb = (const bf16_t*)(P.ws + WS_Z); const int ld = HG ? LDZ1 : LDZ0;
    const int qcol = HG ? h * 128 : 3072 + h * 128, kcol = HG ? 1024 + h * 128 : 3584 + h * 128, vcol = HG ? 2048 + h * 128 : 4096 + h * 256;
    const size_t row0 = (size_t)b * SEQ + n * 64;
#pragma unroll
    for (int i = 0; i < 2; ++i) { const int id = tid + 512 * i, t = id >> 4, ch = id & 15; const bf16_t* rowp = Zb + (row0 + t) * ld;
        R.k[i] = *(const u32x4*)(rowp + kcol + ch * 8);
        if (PC) R.q[i] = *(const u32x4*)(rowp + qcol + ch * 8); }
#pragma unroll
    for (int i = 0; i < V / 64; ++i) { const int id = tid + 512 * i, t = id / VCH, ch = id % VCH;
        R.v[i] = *(const u32x4*)(Zb + (row0 + t) * ld + vcol + ch * 8); }
    if (!HG && tid < 128) { const int t = tid >> 1, hf = tid & 1; R.gl = *(const u32x4*)(Zb + (row0 + t) * ld + 7168 + hf * 8); }
    { const int kc = tid & 127;
      if (!HG) {
#pragma unroll
          for (int r = 0; r < 16; ++r) R.wg[r] = P.gla_w_gate[r * 512 + h * 128 + kc];
          R.bg = P.gla_b_gate[h * 128 + kc];
      } else { R.g0 = P.hgrn_gamma[h * 128 + kc]; R.g1 = P.hgrn_gamma[1024 + h * 128 + kc]; } }
    if (PC) { const bf16_t* usp = us_chunk<HG>(P.ws, cc);
#pragma unroll
        for (int i = 0; i < V / 32; ++i) R.s[i] = *(const u32x4*)(usp + (size_t)(tid + 512 * i) * 8); }
}
template <bool HG, bool PC>
__device__ __forceinline__ void glr_chunk(const Params& P, unsigned char* lds, int cc, int cnext, GlrRegs& R) {
    const int bh = cc >> 5, n = cc & 31;
    constexpr int V = HG ? 128 : 256, VSTR = HG ? 288 : 544, VCH = V / 8;
    unsigned char* RK = lds; unsigned char* RQ = lds + 17408; unsigned char* VV = lds + 34816; bf16_t* SC = (bf16_t*)(lds + 69632);
    float* PART = (float*)(lds + 78848); float* EM = (float*)(lds + 80896); float* ELM = EM + 128; unsigned char* GLb = lds + 82432;
    bf16_t* Ks = (bf16_t*)RK; bf16_t* Qs = (bf16_t*)RQ;
    const int tid = otid(), wid = tid >> 6, lane = tid & 63, fr = lane & 15, fq = lane >> 4, q4 = fr >> 2, p4 = fr & 3;
    const int b = HG ? (bh >> 3) : (bh >> 2), h = HG ? (bh & 7) : (bh & 3);
    const bf16_t* Zb = (const bf16_t*)(P.ws + WS_Z); const int ld = HG ? LDZ1 : LDZ0;
    const int qcol = HG ? h * 128 : 3072 + h * 128, kcol = HG ? 1024 + h * 128 : 3584 + h * 128;
    const int vcol = HG ? 2048 + h * 128 : 4096 + h * 256, ocol = HG ? h * 128 : h * 256;
    float* DV = (float*)(P.ws + WS_DV); float* EMV = (float*)(P.ws + WS_EMV);
    const int c = bh * 32 + n;
    bf16_t* USc = us_chunk<HG>(P.ws, c);
    const size_t row0 = (size_t)b * SEQ + n * 64;
    const int kc = tid & 127, tq = tid >> 7;
    __syncthreads();
#pragma unroll
    for (int i = 0; i < 2; ++i) { const int id = tid + 512 * i, t = id >> 4, ch = id & 15;
        *(u32x4*)(RK + t * 272 + ch * 16) = R.k[i];
        if (PC) *(u32x4*)(RQ + t * 272 + ch * 16) = R.q[i]; }
#pragma unroll
    for (int i = 0; i < V / 64; ++i) { const int id = tid + 512 * i, t = id / VCH, ch = id % VCH;
        *(u32x4*)(VV + t * VSTR + ch * 16) = R.v[i]; }
    if (!HG && tid < 128) { const int t = tid >> 1, hf = tid & 1; *(u32x4*)(GLb + t * 32 + hf * 16) = R.gl; }
    unsigned char* SS = lds + 84480;
    if (PC) {
#pragma unroll
        for (int i = 0; i < V / 32; ++i) { const int id = tid + 512 * i; *(u32x4*)(SS + (id >> 4) * 272 + (id & 15) * 16) = R.s[i]; } }
    unsigned wgp[8]; float bgk = 0.f, lbk = 0.f;
    if (!HG) {
#pragma unroll
        for (int r = 0; r < 8; ++r) wgp[r] = cvt_pk_bf16(R.wg[2 * r], R.wg[2 * r + 1]);
        bgk = R.bg;
    } else {
#pragma unroll
        for (int r = 0; r < 8; ++r) wgp[r] = 0u;
        lbk = sigmoidf_(R.g1 - R.g0);
    }
    if (cnext >= 0) glr_issue<HG, PC>(P, cnext, R, tid);
    __syncthreads();
    float qv[16], kv[16], lg[16];
#pragma unroll
    for (int i = 0; i < 16; ++i) { const int t = tq * 16 + i;
        const float kraw = bf2f(Ks[t * 136 + kc]); const float qraw = PC ? bf2f(Qs[t * 136 + kc]) : 0.f;
        if (HG) { const float f = lbk + (1.0f - lbk) * sigmoidf_(kraw); lg[i] = __logf(f); kv[i] = 1.0f - f; qv[i] = siluf_(qraw); }
        else { const u32x4 g0 = *(const u32x4*)(GLb + t * 32), g1 = *(const u32x4*)(GLb + t * 32 + 16);
            float x = bgk;
            x = dot2bf(g0.x, wgp[0], x); x = dot2bf(g0.y, wgp[1], x); x = dot2bf(g0.z, wgp[2], x); x = dot2bf(g0.w, wgp[3], x);
            x = dot2bf(g1.x, wgp[4], x); x = dot2bf(g1.y, wgp[5], x); x = dot2bf(g1.z, wgp[6], x); x = dot2bf(g1.w, wgp[7], x);
            lg[i] = logsigmoidf_(x) * (1.0f / 16.0f); kv[i] = kraw; qv[i] = qraw * 0.08838834764831845f; } }
    float run = 0.f;
#pragma unroll
    for (int i = 0; i < 16; ++i) { run += lg[i]; lg[i] = run; }
    PART[tq * 128 + kc] = run;
    __syncthreads();
    const float p0 = PART[kc], p1 = PART[128 + kc], p2 = PART[256 + kc], p3 = PART[384 + kc];
    const float off = (tq > 0 ? p0 : 0.f) + (tq > 1 ? p1 : 0.f) + (tq > 2 ? p2 : 0.f);
    const float bmid = p0 + p1, blast = bmid + p2 + p3;
#pragma unroll
    for (int i = 0; i < 16; ++i) { const float bt = off + lg[i]; const int t = tq * 16 + i;
        Ks[t * 136 + kc] = f2bf(kv[i] * __expf(bmid - bt));
        if (PC) Qs[t * 136 + kc] = f2bf(qv[i] * __expf(bt - bmid)); }
    if (!PC && tq == 0) { ELM[kc] = __expf(blast - bmid); DV[(size_t)c * 128 + kc] = __expf(blast); EMV[(size_t)c * 128 + kc] = __expf(bmid); }
    __syncthreads();
    if (!PC) {
        const int k0 = 16 * wid;
        const unsigned char* abase = RK + (8 * fq + q4) * 272 + (k0 + 4 * p4) * 2;
        bf16x8 af[2];
#pragma unroll
        for (int s = 0; s < 2; ++s) { const s16x4 lo = __builtin_amdgcn_ds_read_tr16_b64_v4i16((LAS s16x4*)(abase + (32 * s) * 272));
            const s16x4 hi = __builtin_amdgcn_ds_read_tr16_b64_v4i16((LAS s16x4*)(abase + (32 * s + 4) * 272));
            af[s] = (bf16x8){lo[0], lo[1], lo[2], lo[3], hi[0], hi[1], hi[2], hi[3]}; }
        const f32x4 el = *(const f32x4*)(ELM + k0 + 4 * fq);
#pragma unroll
        for (int vt = 0; vt < V / 16; ++vt) { f32x4 a = {0.f, 0.f, 0.f, 0.f};
            const unsigned char* bbase = VV + (8 * fq + q4) * VSTR + (16 * vt + 4 * p4) * 2;
#pragma unroll
            for (int s = 0; s < 2; ++s) { const s16x4 lo = __builtin_amdgcn_ds_read_tr16_b64_v4i16((LAS s16x4*)(bbase + (32 * s) * VSTR));
                const s16x4 hi = __builtin_amdgcn_ds_read_tr16_b64_v4i16((LAS s16x4*)(bbase + (32 * s + 4) * VSTR));
                const bf16x8 bfv = {lo[0], lo[1], lo[2], lo[3], hi[0], hi[1], hi[2], hi[3]}; a = mfma16(af[s], bfv, a); }
            *(u32x2*)(USc + (size_t)(16 * vt + fr) * 128 + k0 + 4 * fq) = pack4(a * el); }
    } else {
        const float* ng = HG ? P.hgrn_norm_g : P.gla_norm_g;
        const size_t trow = row0 + 16 * (wid & 3) + fr; const bf16_t* grow = Zb + trow * ld + (HG ? 4096 : 6144) + ocol;
        u32x2 gwv[V / 32]; f32x4 gnv[V / 32];
#pragma unroll
        for (int i = 0; i < V / 32; ++i) { const int v0 = 16 * ((wid >> 2) + 2 * i) + 4 * fq; gwv[i] = *(const u32x2*)(grow + v0); gnv[i] = *(const f32x4*)(ng + ocol + v0); }
        { const int it = wid & 3;
#pragma unroll
          for (int jj = 0; jj < 2; ++jj) { const int jt = 2 * (wid >> 2) + jj; f32x4 a = {0.f, 0.f, 0.f, 0.f};
#pragma unroll
              for (int s = 0; s < 4; ++s) { const bf16x8 afr = *(const bf16x8*)(Ks + (16 * jt + fr) * 136 + 32 * s + 8 * fq); const bf16x8 bfv = *(const bf16x8*)(Qs + (16 * it + fr) * 136 + 32 * s + 8 * fq); a = mfma16(afr, bfv, a); }
              const int i = 16 * it + fr, j0 = 16 * jt + 4 * fq;
#pragma unroll
              for (int ri = 0; ri < 4; ++ri) a[ri] = (j0 + ri <= i) ? a[ri] : 0.f;
              *(u32x2*)(SC + i * 72 + j0) = pack4(a); } }
        __syncthreads();
        const int tt = wid & 3;
        bf16x8 qb[4], sb[2];
#pragma unroll
        for (int s = 0; s < 4; ++s) qb[s] = *(const bf16x8*)(Qs + (16 * tt + fr) * 136 + 32 * s + 8 * fq);
#pragma unroll
        for (int s = 0; s < 2; ++s) sb[s] = *(const bf16x8*)(SC + (16 * tt + fr) * 72 + 32 * s + 8 * fq);
        f32x4 acc[V / 32]; float ss = 0.f;
#pragma unroll
        for (int i = 0; i < V / 32; ++i) { const int vt = (wid >> 2) + 2 * i; f32x4 a = {0.f, 0.f, 0.f, 0.f};
            const unsigned char* sp = SS + (16 * vt + fr) * 272 + 16 * fq;
#pragma unroll
            for (int s = 0; s < 4; ++s) { const bf16x8 afr = *(const bf16x8*)(sp + 64 * s); a = mfma16(afr, qb[s], a); }
            const unsigned char* vb = VV + (8 * fq + q4) * VSTR + (16 * vt + 4 * p4) * 2;
#pragma unroll
            for (int s = 0; s < 2; ++s) { const s16x4 lo = __builtin_amdgcn_ds_read_tr16_b64_v4i16((LAS s16x4*)(vb + (32 * s) * VSTR));
                const s16x4 hi = __builtin_amdgcn_ds_read_tr16_b64_v4i16((LAS s16x4*)(vb + (32 * s + 4) * VSTR));
                const bf16x8 afr = {lo[0], lo[1], lo[2], lo[3], hi[0], hi[1], hi[2], hi[3]}; a = mfma16(afr, sb[s], a); }
            acc[i] = a; ss += a[0] * a[0] + a[1] * a[1] + a[2] * a[2] + a[3] * a[3]; }
        ss += __shfl_xor(ss, 16); ss += __shfl_xor(ss, 32);
        if (fq == 0) PART[(wid >> 2) * 64 + 16 * tt + fr] = ss;
        __syncthreads();
        const float tot = PART[16 * tt + fr] + PART[64 + 16 * tt + fr];
        const float rinv = rsqrtf(tot * (1.0f / V) + 1e-6f);
        bf16_t* Yb = (bf16_t*)(P.ws + (HG ? WS_HN : WS_OB));
#pragma unroll
        for (int i = 0; i < V / 32; ++i) { const int vt = (wid >> 2) + 2 * i, v0 = 16 * vt + 4 * fq;
            const u32x2 gw = gwv[i]; const f32x4 gn = gnv[i];
            f32x4 y; y[0] = acc[i][0] * rinv * gn[0] * siluf_(lo_bf(gw.x)); y[1] = acc[i][1] * rinv * gn[1] * siluf_(hi_bf(gw.x));
            y[2] = acc[i][2] * rinv * gn[2] * siluf_(lo_bf(gw.y)); y[3] = acc[i][3] * rinv * gn[3] * siluf_(hi_bf(gw.y));
            *(u32x2*)(Yb + trow * DM + 1024 + ocol + v0) = pack4(y); }
    }
}
template <bool HG>
__device__ __forceinline__ void glr_scan(const Params& P, int bid, int nb, int t0 = 0, int nt = 512) {
    constexpr int V = HG ? 128 : 256;
    const float* __restrict__ DV = (const float*)(P.ws + WS_DV); const float* __restrict__ EMV = (const float*)(P.ws + WS_EMV);
    const int tid = otid();
    for (int gid = bid * nt + tid - t0; gid < 131072; gid += nb * nt) {
        const int kq = gid & 31, v = (gid >> 5) % V, bh = gid / (32 * V);
        f32x4 S = {0.f, 0.f, 0.f, 0.f};
        for (int n0 = 0; n0 < 32; n0 += 16) { u32x2 uw[16]; f32x4 d[16], em[16];
#pragma unroll
            for (int j = 0; j < 16; ++j) { const size_t c = (size_t)bh * 32 + n0 + j; uw[j] = *(const u32x2*)(us_chunk<HG>(P.ws, (int)c) + (size_t)v * 128 + 4 * kq);
                d[j] = *(const f32x4*)(DV + c * 128 + 4 * kq); em[j] = *(const f32x4*)(EMV + c * 128 + 4 * kq); }
#pragma unroll
            for (int j = 0; j < 16; ++j) { const size_t c = (size_t)bh * 32 + n0 + j;
                *(u32x2*)(us_chunk<HG>(P.ws, (int)c) + (size_t)v * 128 + 4 * kq) = pack4(S * em[j]);
                const f32x4 u = {lo_bf(uw[j].x), hi_bf(uw[j].x), lo_bf(uw[j].y), hi_bf(uw[j].y)};
                S = S * d[j] + u; } }
    }
}

__device__ __forceinline__ void gate_l0(const Params& P, int bid, int nb, int w0 = 0, int nw = 8) {
    const int tid_ = otid(); const int wid = (tid_ >> 6) - w0, lane = tid_ & 63;
    const bf16_t* __restrict__ OP = (const bf16_t*)P.out; const float* __restrict__ LSE = (const float*)((const unsigned char*)P.out + DO_LSE);
    const bf16_t* __restrict__ Z = (const bf16_t*)(P.ws + WS_Z); bf16_t* __restrict__ Y = (bf16_t*)(P.ws + WS_OB);
#pragma unroll 2
    for (int token = bid * nw + wid; token < NTOK; token += nb * nw) {
        {
            const int c0 = lane * 16, head = lane >> 3;
            const float l0 = LSE[((size_t)0 * NTOK + token) * 8 + head], l1 = LSE[((size_t)1 * NTOK + token) * 8 + head], l2 = LSE[((size_t)2 * NTOK + token) * 8 + head];
            const float mx = fmaxf(l0, fmaxf(l1, l2)); float w0 = __expf(l0 - mx), w1 = __expf(l1 - mx), w2 = __expf(l2 - mx); const float ws = 1.0f / (w0 + w1 + w2); w0 *= ws; w1 *= ws; w2 *= ws;
#pragma unroll
            for (int hf = 0; hf < 2; ++hf) { const int c = c0 + hf * 8;
                const u32x4 a = *(const u32x4*)(OP + (size_t)token * 1024 + c), bq = *(const u32x4*)(OP + ((size_t)NTOK + token) * 1024 + c), cq = *(const u32x4*)(OP + ((size_t)2 * NTOK + token) * 1024 + c);
                const u32x4 gv = *(const u32x4*)(Z + (size_t)token * LDZ0 + 5120 + c);
                const unsigned aw[4] = {a.x, a.y, a.z, a.w}, bw[4] = {bq.x, bq.y, bq.z, bq.w}, cw[4] = {cq.x, cq.y, cq.z, cq.w}, gw[4] = {gv.x, gv.y, gv.z, gv.w};
                unsigned ow[4];
#pragma unroll
                for (int i = 0; i < 4; ++i) { const float ylo = (w0 * lo_bf(aw[i]) + w1 * lo_bf(bw[i]) + w2 * lo_bf(cw[i])) * siluf_(lo_bf(gw[i])); const float yhi = (w0 * hi_bf(aw[i]) + w1 * hi_bf(bw[i]) + w2 * hi_bf(cw[i])) * siluf_(hi_bf(gw[i])); ow[i] = cvt_pk_bf16(ylo, yhi); }
                *(u32x4*)(Y + (size_t)token * DM + c) = (u32x4){ow[0], ow[1], ow[2], ow[3]}; }
        }
    }
}
__device__ __forceinline__ void s5_disc(const Params& P, int g, int p, float& lr, float& li, float& dt, float& cor, float& coi) {
    lr = P.lam_re[g * 64 + p]; li = P.lam_im[g * 64 + p]; dt = __expf(P.log_dt[g]);
    const float mag = __expf(lr * dt), ang = li * dt; const float ar = mag * __cosf(ang), ai = mag * __sinf(ang);
    const float inv = 1.0f / (lr * lr + li * li); const float nr = ar - 1.0f, ni = ai;
    cor = (nr * lr + ni * li) * inv; coi = (ni * lr - nr * li) * inv;
}
__device__ __forceinline__ void s5_gen(const Params& P, unsigned char* lds, int bid, int nb) {
    float* AP = (float*)lds;
    float* CC = AP + 384;
    float* BB = CC + 2048;
    float* KT = BB + 2048;
    bf16_t* E = (bf16_t*)(P.ws + WS_S5B1); bf16_t* TF = (bf16_t*)(P.ws + WS_S5B2);
    const int tid = otid();
    for (int item = bid; item < 256; item += nb) {
        const int g = item >> 2;
        __syncthreads();
#pragma unroll
        for (int rep = 0; rep < 2; ++rep) { const int idx = tid + rep * 512;
            { const int p = idx >> 4, hp = idx & 15; float lr, li, dt, cr, ci; s5_disc(P, g, p, lr, li, dt, cr, ci);
              const float br = P.b_re[(g * 64 + p) * 16 + hp], bi = P.b_im[(g * 64 + p) * 16 + hp];
              BB[idx * 2] = cr * br - ci * bi; BB[idx * 2 + 1] = cr * bi + ci * br; }
            { const int hh = idx >> 6, p = idx & 63; CC[idx * 2] = P.c_re[(g * 16 + hh) * 64 + p]; CC[idx * 2 + 1] = P.c_im[(g * 16 + hh) * 64 + p]; } }
        float lrp = 0.f, lip = 0.f, dtp = 0.f;
        if (tid < 64) { float cr, ci; s5_disc(P, g, tid, lrp, lip, dtp, cr, ci); }
        for (int tt = 0; tt < 4; ++tt) { const int tau = (item & 3) * 4 + tt;
        if (tid < 64) { const int e3[3] = {tau, tau + 1, 15 - tau};
#pragma unroll
            for (int q = 0; q < 3; ++q) { const float mg = __expf(lrp * dtp * (float)e3[q]), an = lip * dtp * (float)e3[q]; AP[(q * 64 + tid) * 2] = mg * __cosf(an); AP[(q * 64 + tid) * 2 + 1] = mg * __sinf(an); } }
        __syncthreads();
        if (tid < 256) { const int hh = tid >> 4, hp = tid & 15; float s = 0.f;
            for (int p = 0; p < 64; ++p) { const float cr = CC[(hh * 64 + p) * 2], ci = CC[(hh * 64 + p) * 2 + 1], ar = AP[p * 2], ai = AP[p * 2 + 1];
                const float t1r = cr * ar - ci * ai, t1i = cr * ai + ci * ar; s += t1r * BB[(p * 16 + hp) * 2] - t1i * BB[(p * 16 + hp) * 2 + 1]; }
            if (tau == 0 && hh == hp) s += P.s5_d[g * 16 + hh];
            KT[tid] = s;
        } else { const int u = tid - 256;
            {
                const int hh = u >> 4, pg = u & 15; float vals[8];
#pragma unroll
                for (int q = 0; q < 4; ++q) { const int p = pg * 4 + q; const float cr = CC[(hh * 64 + p) * 2], ci = CC[(hh * 64 + p) * 2 + 1], ar = AP[(64 + p) * 2], ai = AP[(64 + p) * 2 + 1];
                    vals[2 * q] = cr * ar - ci * ai; vals[2 * q + 1] = -(cr * ai + ci * ar); }
                u32x4 w; w.x = cvt_pk_bf16(vals[0], vals[1]); w.y = cvt_pk_bf16(vals[2], vals[3]); w.z = cvt_pk_bf16(vals[4], vals[5]); w.w = cvt_pk_bf16(vals[6], vals[7]);
                *(u32x4*)(TF + (size_t)(g * 256 + tau * 16 + hh) * 384 + 256 + pg * 8) = w; }
            {
                const int row = u >> 1, hf = u & 1, p = row >> 1, c = row & 1; const float ar = AP[(128 + p) * 2], ai = AP[(128 + p) * 2 + 1]; float vals[8];
#pragma unroll
                for (int q = 0; q < 8; ++q) { const float br = BB[(p * 16 + hf * 8 + q) * 2], bi = BB[(p * 16 + hf * 8 + q) * 2 + 1]; vals[q] = c ? (ar * bi + ai * br) : (ar * br - ai * bi); }
                u32x4 w; w.x = cvt_pk_bf16(vals[0], vals[1]); w.y = cvt_pk_bf16(vals[2], vals[3]); w.z = cvt_pk_bf16(vals[4], vals[5]); w.w = cvt_pk_bf16(vals[6], vals[7]);
                *(u32x4*)(E + (size_t)(g * 256 + row) * 256 + tau * 16 + hf * 8) = w;
                *(u32x4*)(E + (size_t)(g * 256 + 128 + row) * 256 + tau * 16 + hf * 8) = (u32x4){0u, 0u, 0u, 0u}; }
        }
        __syncthreads();
        const int nblk = (16 - tau) * (tau > 0 ? 2 : 1);
        for (int j = tid; j < nblk * 32; j += 512) { const int blk = j >> 5, rh = j & 31, hrow = rh >> 1, hf = rh & 1;
            const int which = tau > 0 ? (blk & 1) : 0, bi = tau > 0 ? (blk >> 1) : blk;
            u32x4 w = {0u, 0u, 0u, 0u}; int row, col;
            if (which == 0) { row = (bi + tau) * 16 + hrow; col = bi * 16 + hf * 8; const float* kr = KT + hrow * 16 + hf * 8;
                w.x = cvt_pk_bf16(kr[0], kr[1]); w.y = cvt_pk_bf16(kr[2], kr[3]); w.z = cvt_pk_bf16(kr[4], kr[5]); w.w = cvt_pk_bf16(kr[6], kr[7]); }
            else { row = bi * 16 + hrow; col = (bi + tau) * 16 + hf * 8; }
            *(u32x4*)(TF + (size_t)(g * 256 + row) * 384 + col) = w; }
        __syncthreads();
        }
    }
}
__device__ __forceinline__ void s5_scan(const Params& P, int bid, int nb) {
    const int tid = otid(); if (tid < 64) {
    const float* __restrict__ XL = (const float*)(P.ws + WS_XLOC); bf16_t* __restrict__ S5Ap = (bf16_t*)(P.ws + WS_S5A);
    for (int gid = bid * 64 + tid; gid < 16384; gid += nb * 64) {
        const int p = gid & 63, g = (gid >> 6) & 63, b = gid >> 12;
        const float lr = P.lam_re[g * 64 + p], li = P.lam_im[g * 64 + p], dt = __expf(P.log_dt[g]);
        const float mg = __expf(16.0f * lr * dt), an = 16.0f * li * dt; const float ar = mg * __cosf(an), ai = mg * __sinf(an);
        float xr = 0.f, xi = 0.f; const size_t rowb = (size_t)g * 512 + b * 128;
        for (int n0 = 0; n0 < 128; n0 += 32) { f32x2 loc[32];
#pragma unroll
            for (int j = 0; j < 32; ++j) loc[j] = *(const f32x2*)(XL + (rowb + n0 + j) * 128 + 2 * p);
#pragma unroll
            for (int j = 0; j < 32; ++j) { *(unsigned*)(S5Ap + (rowb + n0 + j) * 384 + 256 + 2 * p) = cvt_pk_bf16(xr, xi);
                const float nr = ar * xr - ai * xi + loc[j].x, ni = ar * xi + ai * xr + loc[j].y; xr = nr; xi = ni; } }
    }
    }
}

#define XB_TMO      128
#define XB_XCNT(j)  (256  + 64 * (j))
#define XB_XSUB(j)  (1280 + 64 * (j))
#define XB_XGEN(j)  (2304 + 64 * (j))
#define XB_TOP      3328
#define XB_TOPGEN   3392
#define XCD_BAR_WORDS 3456
#define XB_SPIN_CAP (1u << 18)
__device__ __forceinline__ unsigned xb_ld(unsigned* p)              { return __hip_atomic_load(p, __ATOMIC_RELAXED, __HIP_MEMORY_SCOPE_AGENT); }
__device__ __forceinline__ unsigned xb_add(unsigned* p, unsigned v) { return __hip_atomic_fetch_add(p, v, __ATOMIC_RELAXED, __HIP_MEMORY_SCOPE_AGENT); }
__device__ __forceinline__ unsigned xb_xcc_id() { return (unsigned)__builtin_amdgcn_s_getreg((3 << 11) | 20) & 0xFu; }
#define XB_SPIN(cond, bar) do { unsigned _sp = 0; while (cond) { __builtin_amdgcn_s_sleep(1); \
    if ((++_sp & 255u) == 0u) { if (xb_ld(&(bar)[XB_TMO])) break; if (_sp > XB_SPIN_CAP) { atomicAdd(&(bar)[XB_TMO], 1u); break; } } } } while (0)
__device__ __forceinline__ void xcd_barrier_complete(unsigned* bar, unsigned x, unsigned& nloc, unsigned& nx) {
    const unsigned G = gridDim.x * gridDim.y * gridDim.z;
    unsigned sum, cnt, mine, sp = 0u;
    for (;;) {
        sum = 0u; cnt = 0u; mine = 0u;
#pragma unroll
        for (unsigned j = 0; j < 16; ++j) { const unsigned c = xb_ld(&bar[XB_XCNT(j)]); sum += c; cnt += (c > 0u) ? 1u : 0u; mine = (j == x) ? c : mine; }
        if (sum == G) break;
        __builtin_amdgcn_s_sleep(1);
        if ((++sp & 255u) == 0u) { if (xb_ld(&bar[XB_TMO])) break; if (sp > XB_SPIN_CAP) { atomicAdd(&bar[XB_TMO], 1u); break; } }
    }
    nloc = mine > 0u ? mine : 1u; nx = cnt > 0u ? cnt : 1u;
}
__device__ __forceinline__ void xcd_barrier(unsigned* bar, volatile LAS unsigned* st) {
    asm volatile("s_waitcnt vmcnt(0)" ::: "memory");
    __syncthreads();
    if (threadIdx.x == 0) {
        const unsigned x = xb_xcc_id();
        __builtin_amdgcn_s_waitcnt(0);
        unsigned nloc = st[0], nx = st[1];
        if (nloc == 0u) { xcd_barrier_complete(bar, x, nloc, nx); st[0] = nloc; st[1] = nx; }
        const unsigned old = xb_add(&bar[XB_XSUB(x)], 1u);
        const unsigned gen = old / nloc;
        if (old + 1u == (gen + 1u) * nloc) {
            __builtin_amdgcn_fence(__ATOMIC_RELEASE, "agent");
            asm volatile("s_waitcnt vmcnt(0)" ::: "memory");
            const unsigned og = xb_add(&bar[XB_TOP], 1u);
            const unsigned tg = og / nx;
            if (og + 1u == (tg + 1u) * nx) xb_add(&bar[XB_TOPGEN], 1u);
            else XB_SPIN(xb_ld(&bar[XB_TOPGEN]) == tg, bar);
            __builtin_amdgcn_fence(__ATOMIC_ACQUIRE, "agent");
            xb_add(&bar[XB_XGEN(x)], 1u);
            asm volatile("s_waitcnt vmcnt(0)" ::: "memory");
        } else {
            XB_SPIN(xb_ld(&bar[XB_XGEN(x)]) == gen, bar);
            __builtin_amdgcn_fence(__ATOMIC_ACQUIRE, "agent");
            asm volatile("s_waitcnt vmcnt(0)" ::: "memory");
        }
    }
    __syncthreads();
}

__global__ void __launch_bounds__(512, 2) fwd_megakernel(Params Pk) {
    extern __shared__ __attribute__((aligned(16))) unsigned char lds[];
    LAS unsigned char* glds = (LAS unsigned char*)lds;
    const int ph_lo = Pk.ph_lo, ph_hi = Pk.ph_hi;
    if (threadIdx.x == 0) { volatile LAS unsigned* st0 = (volatile LAS unsigned*)(glds + 155648); st0[0] = 0u; st0[1] = 0u;
        if (ph_hi - ph_lo > 1) (void)xb_add(&((unsigned*)(Pk.ws + WS_BAR))[XB_XCNT(xb_xcc_id())], 1u); }
    __syncthreads();
    if (ph_hi - ph_lo > 1 && blockIdx.x < 64) {
        const char* pc = (const char*)(__builtin_amdgcn_s_getpc() & ~63ull); unsigned accw = 0;
        for (int off = (int)threadIdx.x * 16; off < 208 * 1024; off += 512 * 16) { const u32x4 v = *(const u32x4*)(pc + off); accw += v.x ^ v.y ^ v.z ^ v.w; }
        asm volatile("" :: "v"(accw));
    }
#define WT_IN0 ((bf16_t*)(P.ws + WS_WT_IN0))
#define WT_OUT0 ((bf16_t*)(P.ws + WS_WT_OUT0))
#define WT_IN1 ((bf16_t*)(P.ws + WS_WT_IN1))
#define WT_GLU ((bf16_t*)(P.ws + WS_WT_GLU))
#define WT_OUT1 ((bf16_t*)(P.ws + WS_WT_OUT1))
#define HN ((bf16_t*)(P.ws + WS_HN))
#define Z ((bf16_t*)(P.ws + WS_Z))
#define YC ((bf16_t*)(P.ws + WS_YC))
#define S5A ((bf16_t*)(P.ws + WS_S5A))
#define S5B1 ((bf16_t*)(P.ws + WS_S5B1))
#define S5B2 ((bf16_t*)(P.ws + WS_S5B2))
#define XLOC ((float*)(P.ws + WS_XLOC))
#if defined(__HIP_DEVICE_COMPILE__)
#define PH_LOADP() Params P; { const __attribute__((address_space(4))) unsigned long long* s_ = (const __attribute__((address_space(4))) unsigned long long*)__builtin_amdgcn_kernarg_segment_ptr(); \
        asm volatile("" : "+s"(s_)); unsigned long long* dq_ = (unsigned long long*)&P; _Pragma("unroll") for (int i_ = 0; i_ < (int)(sizeof(Params) / 8); ++i_) dq_[i_] = s_[i_]; }
#else
#define PH_LOADP() const Params P = Pk;
#endif
#define PH_BEGIN(n) if (ph_lo <= (n) && (n) < ph_hi) for (int rep_ = 0; rep_ < ((((DBG_REP) >> (n)) & 1) ? 2 : 1); ++rep_) { \
        if ((n) > ph_lo || rep_) { if (ph_hi > 1000) cg::this_grid().sync(); else xcd_barrier((unsigned*)(Pk.ws + WS_BAR), (volatile LAS unsigned*)(glds + 155648)); } __syncthreads(); \
        int bid = blockIdx.x, nb = gridDim.x; asm volatile("" : "+s"(bid), "+s"(nb)); PH_LOADP()
#define PH_END }
    PH_BEGIN(0)
        rmsnorm_rows<true, 4>(P.x, P.norm_g, HN, bid, nb);
        convert_wt(P.ab_w_in, 2048, 7184, WT_IN0, 7424, 1, (float*)lds, bid, nb);
    PH_END
    PH_BEGIN(1)
        { pg8::StaticOrder S; S.init(NTOK, LDZ0, nb, bid); pg8::EpiZ0 E{Z};
          pg8::gemm_phase(glds, pg8::Gemm{HN, WT_IN0, 2048, 2048, 2048}, S, E); }
        { const int cb = nb == 256 ? bid - 160 : bid, cn = nb == 256 ? 96 : nb;
          if (cb >= 0) { __syncthreads();
            convert_wt(P.ab_w_out, 2048, 2048, WT_OUT0, 2048, 0, (float*)lds, cb, cn);
            convert_wt(P.cd_w_in, 2048, 6144, WT_IN1, 6144, 0, (float*)lds, cb, cn);
            convert_wt(P.w_glu, 1024, 1024, WT_GLU, 1024, 0, (float*)lds, cb, cn); } }
    PH_END
    PH_BEGIN(2)
        if (nb == 256) {
            const int xcd = bid & 7, slot = bid >> 3;
#define ATT_U(j) ((xcd + 8 * ((j) / 48)) * 48 + (j) % 48)
            AttnRegs R; attn_issue(Z, ATT_U(slot), R, otid());
            for (int j = slot; j < 192; j += 32) attn_unit(Z, (bf16_t*)P.out, (float*)((unsigned char*)P.out + DO_LSE), lds, ATT_U(j), (j + 32 < 192) ? ATT_U(j + 32) : -1, R);
#undef ATT_U
        } else { AttnRegs R; if (bid < 1536) attn_issue(Z, bid, R, otid());
          for (int u = bid; u < 1536; u += nb) attn_unit(Z, (bf16_t*)P.out, (float*)((unsigned char*)P.out + DO_LSE), lds, u, (u + nb < 1536) ? u + nb : -1, R); }
        { GlrRegs G; if (bid < 512) glr_issue<false, false>(P, bid, G, otid());
          for (int c = bid; c < 512; c += nb) glr_chunk<false, false>(P, lds, c, (c + nb < 512) ? c + nb : -1, G); }
    PH_END
    PH_BEGIN(3)
        if (otid() < 256) glr_scan<false>(P, bid, nb, 0, 256);
        else gate_l0(P, bid, nb, 4, 4);
        s5_gen(P, lds, bid, nb);
    PH_END
    PH_BEGIN(4)
        { GlrRegs G; if (bid < 512) glr_issue<false, true>(P, bid, G, otid());
          for (int c = bid; c < 512; c += nb) glr_chunk<false, true>(P, lds, c, (c + nb < 512) ? c + nb : -1, G); }
    PH_END
    PH_BEGIN(6)
        pg8::StaticOrder S; S.init(NTOK, DM, nb, bid);
        if (nb == 256) { pg8::EpiNorm<false> E{P.x, P.out, HN, P.norm_g + DM, (float*)(P.ws + WS_XS), (unsigned*)(P.ws + WS_CNT)};
            pg8::gemm_phase(glds, pg8::Gemm{(const bf16_t*)(P.ws + WS_OB), WT_OUT0, 2048, 2048, 2048}, S, E); }
        else { pg8::EpiRes E{P.x, P.out};
            pg8::gemm_phase(glds, pg8::Gemm{(const bf16_t*)(P.ws + WS_OB), WT_OUT0, 2048, 2048, 2048}, S, E); }
    PH_END
    if (gridDim.x != 256) {
    PH_BEGIN(7)
        rmsnorm_rows<true>(P.out, P.norm_g + DM, HN, bid, nb);
    PH_END
    }
    PH_BEGIN(8)
        pg8::StaticOrder S; S.init(NTOK, 6144, nb, bid); pg8::EpiZ1 E{Z, S5A};
        pg8::gemm_phase(glds, pg8::Gemm{HN, WT_IN1, 2048, 2048, 2048}, S, E);
    PH_END
    PH_BEGIN(9)
        { pg8::DiagOrder S{128, nb, bid}; pg8::EpiXloc E{XLOC};
          pg8::gemm_phase(glds, pg8::Gemm{S5A, S5B1, 384, 256, 256}, S, E); }
        { GlrRegs G; if (bid < 1024) glr_issue<true, false>(P, bid, G, otid());
          for (int c = bid; c < 1024; c += nb) glr_chunk<true, false>(P, lds, c, (c + nb < 1024) ? c + nb : -1, G); }
        __syncthreads();
        convert_wt(P.cd_w_out, 2048, 2048, WT_OUT1, 2048, 0, (float*)lds, bid, nb);
    PH_END
    PH_BEGIN(10)
        if (otid() < 64) s5_scan(P, bid, nb);
        else glr_scan<true>(P, bid, nb, 64, 448);
    PH_END
    PH_BEGIN(11)
        { pg8::DiagOrder S{128, nb, bid}; pg8::EpiS2 E{YC};
          pg8::gemm_phase(glds, pg8::Gemm{S5A, S5B2, 384, 384, 384}, S, E); }
        if (nb == 256) { const int c0 = bid < 128 ? bid : 128 + 2 * (bid - 128), cn = bid < 128 ? 1 : 2;
            GlrRegs G; glr_issue<true, true>(P, c0, G, otid());
            for (int c = c0; c < c0 + cn; ++c) glr_chunk<true, true>(P, lds, c, (c + 1 < c0 + cn) ? c + 1 : -1, G); }
        else { GlrRegs G; if (bid < 1024) glr_issue<true, true>(P, bid, G, otid());
            for (int c = bid; c < 1024; c += nb) glr_chunk<true, true>(P, lds, c, (c + nb < 1024) ? c + nb : -1, G); }
    PH_END
    PH_BEGIN(12)
        if (nb != 256 || bid < 128) { pg8::StaticOrder S; S.init(NTOK, 1024, nb == 256 ? 128 : nb, bid); pg8::EpiGlu E{YC, Z, P.b_glu, HN};
            pg8::gemm_phase(glds, pg8::Gemm{YC, WT_GLU, 1024, 1024, 1024}, S, E); }
        else { const int c0 = 384 + 5 * (bid - 128);
            GlrRegs G; glr_issue<true, true>(P, c0, G, otid());
            for (int c = c0; c < c0 + 5; ++c) glr_chunk<true, true>(P, lds, c, (c + 1 < c0 + 5) ? c + 1 : -1, G); }
    PH_END
    PH_BEGIN(13)
        pg8::StaticOrder S; S.init(NTOK, DM, nb, bid);
        if (nb == 256) { pg8::EpiNorm<true> E{P.out, P.out, nullptr, P.final_g, (float*)(P.ws + WS_XS + 262144), (unsigned*)(P.ws + WS_CNT + 8192)};
            pg8::gemm_phase(glds, pg8::Gemm{HN, WT_OUT1, 2048, 2048, 2048}, S, E); }
        else { pg8::EpiRes E{P.out, P.out};
            pg8::gemm_phase(glds, pg8::Gemm{HN, WT_OUT1, 2048, 2048, 2048}, S, E); }
    PH_END
    if (gridDim.x != 256) {
    PH_BEGIN(14)
        rmsnorm_rows<false>(P.out, P.final_g, P.out, bid, nb);
    PH_END
    }
}

extern "C" void kernel_launch(void* const* d_in, const int* in_sizes, int n_in, void* d_out, int out_size, void* d_ws, size_t ws_size, hipStream_t stream) {
    static int grid = 0;
    if (grid == 0) {
        if (n_in != 22 || out_size != NTOK * DM || ws_size < WS_TOP) { fprintf(stderr, "kernel_launch: unexpected shapes n_in %d out %d ws %zu\n", n_in, out_size, ws_size); grid = -1; return; }
        int dev = 0, cus = 0, per_cu = 0;
        (void)hipGetDevice(&dev); (void)hipDeviceGetAttribute(&cus, hipDeviceAttributeMultiprocessorCount, dev);
        if (hipFuncSetAttribute((const void*)fwd_megakernel, hipFuncAttributeMaxDynamicSharedMemorySize, LDS_BYTES) != hipSuccess) { fprintf(stderr, "kernel_launch: hipFuncSetAttribute failed\n"); grid = -1; return; }
        if (hipOccupancyMaxActiveBlocksPerMultiprocessor(&per_cu, (const void*)fwd_megakernel, 512, LDS_BYTES) != hipSuccess || per_cu < 1) { fprintf(stderr, "kernel_launch: occupancy query says %d\n", per_cu); per_cu = 1; }
        (void)hipGetLastError();
        if (cus <= 0) cus = 256;
        grid = cus;
    }
    if (grid < 0) return;
    Params p{};
    const float** pf = (const float**)&p;
    for (int i = 0; i < 22; ++i) pf[i] = (const float*)d_in[i];
    p.out = (float*)d_out; p.ws = (unsigned char*)d_ws;
#if N_LAUNCH_MODE == 1
    (void)hipMemsetAsync((unsigned char*)d_ws + WS_BAR, 0, 32768, stream);
    p.ph_lo = 0; p.ph_hi = NPHASE;
    void* args[] = {&p};
    hipError_t e = hipLaunchCooperativeKernel((const void*)fwd_megakernel, dim3(grid), dim3(512), args, LDS_BYTES, stream);
    if (e != hipSuccess) fprintf(stderr, "cooperative launch failed: %s (grid %d)\n", hipGetErrorString(e), grid);
#else
    for (int ph = 0; ph < NPHASE; ++ph) { p.ph_lo = ph; p.ph_hi = ph + 1; hipLaunchKernelGGL(fwd_megakernel, dim3(grid), dim3(512), LDS_BYTES, stream, p); }
#endif
}
```

```cpp
#include <hip/hip_runtime.h>
#include <hip/hip_cooperative_groups.h>
#include <cstdio>
#include <cstdint>
namespace cg = cooperative_groups;

#ifndef DBG_REP
#define DBG_REP 0
#endif
#ifndef N_LAUNCH_MODE
#define N_LAUNCH_MODE 1
#endif

typedef unsigned short bf16_t;
typedef short bf16x8 __attribute__((ext_vector_type(8)));
typedef short s16x4 __attribute__((ext_vector_type(4)));
typedef float f32x4 __attribute__((ext_vector_type(4)));
typedef float f32x2 __attribute__((ext_vector_type(2)));
typedef unsigned u32x4 __attribute__((ext_vector_type(4)));
typedef unsigned u32x2 __attribute__((ext_vector_type(2)));
#define LAS __attribute__((address_space(3)))

constexpr int NTOK = 8192, DM = 2048, SEQ = 2048;
constexpr int LDZ0 = 7424, LDZ1 = 5120;
constexpr int LDS_BYTES = 155648 + 16;
constexpr int NPHASE = 15;

constexpr size_t WS_WT_IN0 = 0;
constexpr size_t WS_WT_OUT0 = 30408704;
constexpr size_t WS_WT_IN1 = 38797312;
constexpr size_t WS_WT_GLU = 63963136;
constexpr size_t WS_WT_OUT1 = 66060288;
constexpr size_t WS_HN = 74448896;
constexpr size_t WS_Z = 108003328;
constexpr size_t WS_OB = 229638144;
constexpr size_t WS_YC = 246415360;
constexpr size_t WS_END = 263192576;
constexpr size_t WS_S5B1 = 0;
constexpr size_t WS_S5B2 = 8388608;
constexpr size_t WS_XLOC = 20971520;
constexpr size_t WS_S5A = WS_Z + 83886080;
constexpr size_t DO_LSE = 50331648;

struct Params {
    const float* x; const float* norm_g; const float* final_g; const float* ab_w_in; const float* gla_w_gate; const float* gla_b_gate;
    const float* gla_norm_g; const float* ab_w_out; const float* cd_w_in; const float* lam_re; const float* lam_im; const float* log_dt;
    const float* b_re; const float* b_im; const float* c_re; const float* c_im; const float* s5_d; const float* w_glu; const float* b_glu;
    const float* hgrn_gamma; const float* hgrn_norm_g; const float* cd_w_out;
    float* out; unsigned char* ws;
    int ph_lo, ph_hi;
};

__device__ __forceinline__ int otid() { int t = threadIdx.x; asm volatile("" : "+v"(t)); return t; }
__device__ __forceinline__ float bf2f(bf16_t b) { return __uint_as_float(((unsigned)b) << 16); }
typedef __bf16 bf16v2_t __attribute__((ext_vector_type(2)));
__device__ __forceinline__ unsigned cvt_pk_bf16(float lo, float hi) { bf16v2_t v = {(__bf16)lo, (__bf16)hi}; return __builtin_bit_cast(unsigned, v); }
__device__ __forceinline__ bf16_t f2bf(float f) { return (bf16_t)(cvt_pk_bf16(f, 0.f) & 0xffffu); }
__device__ __forceinline__ float lo_bf(unsigned w) { return __uint_as_float(w << 16); }
__device__ __forceinline__ float hi_bf(unsigned w) { return __uint_as_float(w & 0xffff0000u); }
__device__ __forceinline__ float sigmoidf_(float x) { return __builtin_amdgcn_rcpf(1.0f + __expf(-x)); }
__device__ __forceinline__ float siluf_(float x) { return x * sigmoidf_(x); }
__device__ __forceinline__ float logsigmoidf_(float x) { return fminf(x, 0.f) - __logf(1.0f + __expf(-fabsf(x))); }
typedef __bf16 bf16p2_t __attribute__((ext_vector_type(2)));
__device__ __forceinline__ float dot2bf(unsigned a, unsigned b, float c) { return __builtin_amdgcn_fdot2_f32_bf16(__builtin_bit_cast(bf16p2_t, a), __builtin_bit_cast(bf16p2_t, b), c, false); }
__device__ __forceinline__ f32x4 mfma16(bf16x8 a, bf16x8 b, f32x4 c) { return __builtin_amdgcn_mfma_f32_16x16x32_bf16(a, b, c, 0, 0, 0); }
__device__ __forceinline__ u32x2 pack4(f32x4 v) { u32x2 w; w.x = cvt_pk_bf16(v[0], v[1]); w.y = cvt_pk_bf16(v[2], v[3]); return w; }

__device__ __forceinline__ int map_col(int mode, int n, int nsrc) {
    if (mode == 1) { if (n < 5120) return n; if (n < 7168) return n + 16; if (n < 7184) return n - 2048; return -1; }
    return n < nsrc ? n : -1;
}
__device__ __forceinline__ void convert_wt(const float* __restrict__ W, int K, int Nsrc, bf16_t* __restrict__ WT, int Ndst, int mode, float* tile, int bid, int nb) {
    const int tid = otid(); const int tk = K / 64, tn = Ndst / 256, total = tk * tn;
    const int nn = tid & 63, kk = tid >> 6, n2 = tid >> 3, kq = tid & 7;
    float v[4][8];
#define CW_ISSUE(it_) do { const int n0_ = ((it_) / tk) * 256, k0_ = ((it_) % tk) * 64; _Pragma("unroll") for (int q = 0; q < 4; ++q) { const int sc = map_col(mode, n0_ + q * 64 + nn, Nsrc); \
        _Pragma("unroll") for (int i = 0; i < 8; ++i) v[q][i] = sc >= 0 ? __builtin_nontemporal_load(W + (size_t)(k0_ + kk * 8 + i) * Nsrc + sc) : 0.f; } } while (0)
    int it = bid; if (it < total) CW_ISSUE(it);
    for (; it < total; it += nb) {
        const int n0 = (it / tk) * 256, k0 = (it % tk) * 64;
#pragma unroll
        for (int q = 0; q < 4; ++q)
#pragma unroll
            for (int i = 0; i < 8; ++i) tile[q * 4160 + (kk * 8 + i) * 65 + nn] = v[q][i];
        if (it + nb < total) CW_ISSUE(it + nb);
        __syncthreads();
#pragma unroll
        for (int q = 0; q < 4; ++q) { float r[8];
#pragma unroll
            for (int j = 0; j < 8; ++j) r[j] = tile[q * 4160 + (kq * 8 + j) * 65 + n2];
            u32x4 w; w.x = cvt_pk_bf16(r[0], r[1]); w.y = cvt_pk_bf16(r[2], r[3]); w.z = cvt_pk_bf16(r[4], r[5]); w.w = cvt_pk_bf16(r[6], r[7]);
            *(u32x4*)(WT + (size_t)(n0 + q * 64 + n2) * K + k0 + kq * 8) = w; }
        __syncthreads();
    }
#undef CW_ISSUE
}
template <bool OUT_BF16, int RPT = 2>
__device__ __forceinline__ void rmsnorm_rows(const float* X, const float* __restrict__ g, void* outp, int bid, int nb) {
    const int tid_ = otid(); const int wid = tid_ >> 6, lane = tid_ & 63;
    const int step = nb * 8;
    for (int row = bid * 8 + wid; row < NTOK; row += RPT * step) {
        f32x4 v[RPT][8]; float ss[RPT]; int rr[RPT]; bool has[RPT];
#pragma unroll
        for (int r = 0; r < RPT; ++r) { rr[r] = row + r * step; has[r] = rr[r] < NTOK; if (!has[r]) rr[r] = row; }
#pragma unroll
        for (int r = 0; r < RPT; ++r)
#pragma unroll
            for (int i = 0; i < 8; ++i) v[r][i] = *(const f32x4*)(X + (size_t)rr[r] * DM + (i * 64 + lane) * 4);
#pragma unroll
        for (int r = 0; r < RPT; ++r) { float s = 0.f;
#pragma unroll
            for (int i = 0; i < 8; ++i) s += v[r][i][0] * v[r][i][0] + v[r][i][1] * v[r][i][1] + v[r][i][2] * v[r][i][2] + v[r][i][3] * v[r][i][3];
#pragma unroll
            for (int o = 32; o >= 1; o >>= 1) s += __shfl_xor(s, o);
            ss[r] = rsqrtf(s * (1.0f / DM) + 1e-6f); }
#pragma unroll
        for (int i = 0; i < 8; ++i) { const f32x4 gg = *(const f32x4*)(g + (i * 64 + lane) * 4);
#pragma unroll
            for (int r = 0; r < RPT; ++r) if (has[r]) {
                if (OUT_BF16) *(u32x2*)((bf16_t*)outp + (size_t)rr[r] * DM + (i * 64 + lane) * 4) = pack4(v[r][i] * ss[r] * gg);
                else *(f32x4*)((float*)outp + (size_t)rr[r] * DM + (i * 64 + lane) * 4) = v[r][i] * ss[r] * gg; } }
    }
}

namespace pg8 {
constexpr int BM = 256, BK = 64, HALF = 128, HTB = HALF * BK * 2, STAGE_BYTES = 8 * HTB, NXCD = 8, WGM = 4;
__device__ __forceinline__ int lds_byte(int r, int c) { const int st = (r >> 4) * 2 + (c >> 5), rr = r & 15, cc = c & 31, ob = rr * 64 + cc * 2; return st * 1024 + (ob ^ (((ob >> 9) & 1) << 5)); }
__device__ __forceinline__ void stage_rc(int b, int& R, int& C) { const int st = b / 1024, sb = b % 1024, swz = sb ^ (((sb >> 9) & 1) << 5); R = (st >> 1) * 16 + swz / 64; C = (st & 1) * 32 + (swz % 64) / 2; }
__device__ __forceinline__ int perm32(int rho) { const int n = rho >> 4, i = rho & 15; return 8 * (i >> 2) + 4 * n + (i & 3); }
struct Unit { int pm, pn; };
struct Gemm { const bf16_t* A; const bf16_t* Bt; int lda, ldb, K; };
struct StaticOrder {
    int nM, nN, nwg, G, c;
    __device__ void init(int M, int N, int G_, int c_) { nM = M / BM; nN = N / BM; nwg = nM * nN; G = G_; c = c_; }
    __device__ bool next(int i, Unit& u) const {
        const long L = (long)i * G + c; if (c < 0 || L >= nwg) return false;
        int wgid = (int)L; { const int q = nwg / NXCD, r = nwg % NXCD, xcd = wgid % NXCD, off = wgid / NXCD; wgid = (xcd < r ? xcd * (q + 1) : r * (q + 1) + (xcd - r) * q) + off; }
        const int nig = WGM * nN, gid = wgid / nig, fm = gid * WGM, gsz = (nM - fm) < WGM ? (nM - fm) : WGM;
        u.pm = fm + ((wgid % nig) % gsz); u.pn = (wgid % nig) / gsz; return true;
    }
};
struct DiagOrder {
    int n, G, c;
    __device__ bool next(int i, Unit& u) const { const int L = i * G + c; if (c < 0 || L >= n) return false; u.pm = L; u.pn = L >> 1; return true; }
};

struct EpiZ0 {
    static constexpr bool PERM = true, AFTER_DRAIN = false, ACC_INIT = false;
    bf16_t* O;
    __device__ __forceinline__ void operator()(const f32x4 (&acc)[2][2][4][2], const Unit& u, int wr, int wc, int fr, int fq) const {
        const int row0 = u.pm * BM + wr * 64 + fr, col0 = u.pn * BM + wc * 32 + 8 * fq;
#pragma unroll
        for (int ai = 0; ai < 2; ++ai)
#pragma unroll
            for (int m = 0; m < 4; ++m) { bf16_t* rowp = O + (size_t)(row0 + ai * HALF + m * 16) * LDZ0 + col0;
#pragma unroll
                for (int bj = 0; bj < 2; ++bj) { const f32x4 v0 = acc[ai][bj][m][0], v1 = acc[ai][bj][m][1];
                    u32x4 w; w.x = cvt_pk_bf16(v0[0], v0[1]); w.y = cvt_pk_bf16(v0[2], v0[3]); w.z = cvt_pk_bf16(v1[0], v1[1]); w.w = cvt_pk_bf16(v1[2], v1[3]);
                    *(u32x4*)(rowp + bj * HALF) = w; } }
    }
};
struct EpiZ1 {
    static constexpr bool PERM = true, AFTER_DRAIN = false, ACC_INIT = false;
    bf16_t* Z1; bf16_t* S5A;
    __device__ __forceinline__ void operator()(const f32x4 (&acc)[2][2][4][2], const Unit& u, int wr, int wc, int fr, int fq) const {
        const int row0 = u.pm * BM + wr * 64 + fr, col0 = u.pn * BM + wc * 32 + 8 * fq;
#pragma unroll
        for (int ai = 0; ai < 2; ++ai)
#pragma unroll
            for (int m = 0; m < 4; ++m) { const int t = row0 + ai * HALF + m * 16;
#pragma unroll
                for (int bj = 0; bj < 2; ++bj) { const f32x4 v0 = acc[ai][bj][m][0], v1 = acc[ai][bj][m][1];
                    u32x4 w; w.x = cvt_pk_bf16(v0[0], v0[1]); w.y = cvt_pk_bf16(v0[2], v0[3]); w.z = cvt_pk_bf16(v1[0], v1[1]); w.w = cvt_pk_bf16(v1[2], v1[3]);
                    const int c = col0 + bj * HALF;
                    if (u.pn < 4) *(u32x4*)(S5A + ((size_t)((c >> 4) * 512 + (t >> 4))) * 384 + (t & 15) * 16 + (c & 15)) = w;
                    else *(u32x4*)(Z1 + (size_t)t * LDZ1 + (c - 1024)) = w; } }
    }
};
struct EpiRes {
    static constexpr bool PERM = false, AFTER_DRAIN = false, ACC_INIT = false;
    const float* base; float* out;
    __device__ __forceinline__ void operator()(const f32x4 (&acc)[2][2][4][2], const Unit& u, int wr, int wc, int fr, int fq) const {
        const int row0 = u.pm * BM + wr * 64 + fr, col0 = u.pn * BM + wc * 32 + 4 * fq;
#pragma unroll
        for (int ai = 0; ai < 2; ++ai)
#pragma unroll
            for (int m = 0; m < 4; ++m) { const size_t off = (size_t)(row0 + ai * HALF + m * 16) * DM + col0;
#pragma unroll
                for (int bj = 0; bj < 2; ++bj)
#pragma unroll
                    for (int n = 0; n < 2; ++n) { const f32x4 bs = *(const f32x4*)(base + off + bj * HALF + n * 16); *(f32x4*)(out + off + bj * HALF + n * 16) = bs + acc[ai][bj][m][n]; } }
    }
};
struct EpiXloc {
    static constexpr bool PERM = false, AFTER_DRAIN = false, ACC_INIT = false;
    float* X;
    __device__ __forceinline__ void operator()(const f32x4 (&acc)[2][2][4][2], const Unit& u, int wr, int wc, int fr, int fq) const {
        const int row0 = u.pm * BM + wr * 64 + fr, col0 = wc * 32 + 4 * fq;
#pragma unroll
        for (int ai = 0; ai < 2; ++ai)
#pragma unroll
            for (int m = 0; m < 4; ++m) { float* rowp = X + (size_t)(row0 + ai * HALF + m * 16) * 128 + col0;
#pragma unroll
                for (int n = 0; n < 2; ++n) *(f32x4*)(rowp + n * 16) = acc[ai][0][m][n]; }
    }
};
__device__ __forceinline__ float gelu_tanh(float y) { const float z = 1.5957691216057308f * (y + 0.044715f * y * y * y); return y * __builtin_amdgcn_rcpf(1.0f + __expf(-z)); }
struct EpiS2 {
    static constexpr bool PERM = true, AFTER_DRAIN = false, ACC_INIT = false;
    bf16_t* YC;
    __device__ __forceinline__ void operator()(const f32x4 (&acc)[2][2][4][2], const Unit& u, int wr, int wc, int fr, int fq) const {
        const int row0 = u.pm * BM + wr * 64 + fr, col0 = wc * 32 + 8 * fq;
#pragma unroll
        for (int ai = 0; ai < 2; ++ai)
#pragma unroll
            for (int m = 0; m < 4; ++m) { const int R = row0 + ai * HALF + m * 16, g = R >> 9, ch = R & 511;
#pragma unroll
                for (int bj = 0; bj < 2; ++bj) { const f32x4 v0 = acc[ai][bj][m][0], v1 = acc[ai][bj][m][1];
                    u32x4 w; w.x = cvt_pk_bf16(gelu_tanh(v0[0]), gelu_tanh(v0[1])); w.y = cvt_pk_bf16(gelu_tanh(v0[2]), gelu_tanh(v0[3]));
                    w.z = cvt_pk_bf16(gelu_tanh(v1[0]), gelu_tanh(v1[1])); w.w = cvt_pk_bf16(gelu_tanh(v1[2]), gelu_tanh(v1[3]));
                    const int c = col0 + bj * HALF;
                    *(u32x4*)(YC + (size_t)(ch * 16 + (c >> 4)) * 1024 + g * 16 + (c & 15)) = w; } }
    }
};
struct EpiGlu {
    static constexpr bool PERM = true, AFTER_DRAIN = false, ACC_INIT = false;
    const bf16_t* YC; const bf16_t* Z1; const float* bglu; bf16_t* Y;
    static __device__ __forceinline__ float sg(float y, float v, float g) { return y * g * __builtin_amdgcn_rcpf((1.0f + __expf(-v)) * (1.0f + __expf(-g))); }
    __device__ __forceinline__ void operator()(const f32x4 (&acc)[2][2][4][2], const Unit& u, int wr, int wc, int fr, int fq) const {
        const int row0 = u.pm * BM + wr * 64 + fr, col0 = u.pn * BM + wc * 32 + 8 * fq;
        f32x4 bb[2][2];
#pragma unroll
        for (int bj = 0; bj < 2; ++bj) { bb[bj][0] = *(const f32x4*)(bglu + col0 + bj * HALF); bb[bj][1] = *(const f32x4*)(bglu + col0 + bj * HALF + 4); }
#pragma unroll
        for (int ai = 0; ai < 2; ++ai)
#pragma unroll
            for (int m = 0; m < 4; ++m) { const int t = row0 + ai * HALF + m * 16;
#pragma unroll
                for (int bj = 0; bj < 2; ++bj) { const int c = col0 + bj * HALF;
                    const u32x4 yv = *(const u32x4*)(YC + (size_t)t * 1024 + c); const u32x4 gv = *(const u32x4*)(Z1 + (size_t)t * LDZ1 + 3072 + c);
                    const f32x4 v0 = acc[ai][bj][m][0] + bb[bj][0], v1 = acc[ai][bj][m][1] + bb[bj][1];
                    float r[8];
                    r[0] = sg(lo_bf(yv.x), v0[0], lo_bf(gv.x)); r[1] = sg(hi_bf(yv.x), v0[1], hi_bf(gv.x));
                    r[2] = sg(lo_bf(yv.y), v0[2], lo_bf(gv.y)); r[3] = sg(hi_bf(yv.y), v0[3], hi_bf(gv.y));
                    r[4] = sg(lo_bf(yv.z), v1[0], lo_bf(gv.z)); r[5] = sg(hi_bf(yv.z), v1[1], hi_bf(gv.z));
                    r[6] = sg(lo_bf(yv.w), v1[2], lo_bf(gv.w)); r[7] = sg(hi_bf(yv.w), v1[3], hi_bf(gv.w));
                    u32x4 w; w.x = cvt_pk_bf16(r[0], r[1]); w.y = cvt_pk_bf16(r[2], r[3]); w.z = cvt_pk_bf16(r[4], r[5]); w.w = cvt_pk_bf16(r[6], r[7]);
                    *(u32x4*)(Y + (size_t)t * DM + c) = w; } }
    }
};
template <bool FINAL> struct EpiNorm {
    static constexpr bool PERM = false, AFTER_DRAIN = true, ACC_INIT = true;
    const float* base; float* hout; bf16_t* nout; const float* g; float* xs; unsigned* cnt;
    __device__ __forceinline__ void init(f32x4 (&acc)[2][2][4][2], const Unit& u, int wr, int wc, int fr, int fq) const {
        const int row0 = u.pm * BM + wr * 64 + fr, col0 = u.pn * BM + wc * 32 + 4 * fq;
#pragma unroll
        for (int ai = 0; ai < 2; ++ai)
#pragma unroll
            for (int m = 0; m < 4; ++m) { const size_t off = (size_t)(row0 + ai * HALF + m * 16) * DM + col0;
#pragma unroll
                for (int bj = 0; bj < 2; ++bj)
#pragma unroll
                    for (int n = 0; n < 2; ++n) acc[ai][bj][m][n] = *(const f32x4*)(base + off + bj * HALF + n * 16); }
    }
    __device__ __forceinline__ void operator()(const f32x4 (&)[2][2][4][2], const Unit&, int, int, int, int) const {}
    __device__ __forceinline__ void fused(f32x4 (&acc)[2][2][4][2], const Unit& u, int wr, int wc, int fr, int fq, LAS unsigned char* lds, int wid, int lane) const {
        LAS float* PT = (LAS float*)lds;
        LAS float* ST = (LAS float*)(lds + 4096);
        const int row0 = u.pm * BM + wr * 64 + fr, col0 = u.pn * BM + wc * 32 + 4 * fq;
#pragma unroll
        for (int ai = 0; ai < 2; ++ai)
#pragma unroll
            for (int m = 0; m < 4; ++m) { const size_t off = (size_t)(row0 + ai * HALF + m * 16) * DM + col0; float s = 0.f;
#pragma unroll
                for (int bj = 0; bj < 2; ++bj)
#pragma unroll
                    for (int n = 0; n < 2; ++n) { const f32x4 h = acc[ai][bj][m][n];
                        s += h[0] * h[0] + h[1] * h[1] + h[2] * h[2] + h[3] * h[3]; }
                s += __shfl_xor(s, 16); s += __shfl_xor(s, 32);
                if (fq == 0) PT[(ai * HALF + wr * 64 + m * 16 + fr) * 4 + wc] = s; }
        __syncthreads();
        const int row = wid * 32 + (lane & 31);
        if (lane < 32) { const float tot = (PT[row * 4] + PT[row * 4 + 1]) + (PT[row * 4 + 2] + PT[row * 4 + 3]);
            __hip_atomic_store(xs + ((size_t)(u.pm * BM + row)) * 8 + u.pn, tot, __ATOMIC_RELAXED, __HIP_MEMORY_SCOPE_AGENT); }
        asm volatile("s_waitcnt vmcnt(0)" ::: "memory");
        if (lane == 0) __hip_atomic_fetch_add(cnt + 64 * u.pm, 1u, __ATOMIC_RELAXED, __HIP_MEMORY_SCOPE_AGENT);
        if (wid == 0) { unsigned sp = 0;
            while ((unsigned)__builtin_amdgcn_readfirstlane(__hip_atomic_load(cnt + 64 * u.pm, __ATOMIC_RELAXED, __HIP_MEMORY_SCOPE_AGENT)) < 64u) { __builtin_amdgcn_s_sleep(2); if (++sp > (1u << 22)) break; }
            __builtin_amdgcn_fence(__ATOMIC_ACQUIRE, "agent");
            asm volatile("s_waitcnt vmcnt(0)" ::: "memory"); }
        __syncthreads();
        if (lane < 32) { const float* sl = xs + ((size_t)(u.pm * BM + row)) * 8; float tot = 0.f;
#pragma unroll
            for (int t = 0; t < 8; ++t) tot += __hip_atomic_load(sl + t, __ATOMIC_RELAXED, __HIP_MEMORY_SCOPE_AGENT);
            ST[row] = rsqrtf(tot * (1.0f / DM) + 1e-6f); }
        __syncthreads();
        f32x4 ggv[2][2];
#pragma unroll
        for (int bj = 0; bj < 2; ++bj)
#pragma unroll
            for (int n = 0; n < 2; ++n) ggv[bj][n] = *(const f32x4*)(g + col0 + bj * HALF + n * 16);
#pragma unroll
        for (int ai = 0; ai < 2; ++ai)
#pragma unroll
            for (int m = 0; m < 4; ++m) { const int r = ai * HALF + wr * 64 + m * 16 + fr; const float rinv = ST[r]; const size_t off = (size_t)(u.pm * BM + r) * DM + col0;
#pragma unroll
                for (int bj = 0; bj < 2; ++bj)
#pragma unroll
                    for (int n = 0; n < 2; ++n) { const f32x4 gg = ggv[bj][n]; const f32x4 h = acc[ai][bj][m][n];
                        if (FINAL) *(f32x4*)(hout + off + bj * HALF + n * 16) = h * rinv * gg;
                        else { *(f32x4*)(hout + off + bj * HALF + n * 16) = h; *(u32x2*)(nout + off + bj * HALF + n * 16) = pack4(h * rinv * gg); } }
                }
    }
};

template <class Epi, class Sched>
__device__ __forceinline__ void gemm_phase(LAS unsigned char* lds, const Gemm g, const Sched& S, const Epi& E) {
    const int tid = otid(), wid = __builtin_amdgcn_readfirstlane(tid >> 6), lane = tid & 63, wr = wid >> 2, wc = wid & 3, fr = lane & 15, fq = lane >> 4;
    const int K = g.K, nt = K / BK;
    unsigned voffA[2], voffB[2];
#pragma unroll
    for (int i = 0; i < 2; ++i) { int R, C; stage_rc(tid * 16 + i * 8192, R, C); const int Rb = Epi::PERM ? ((R & ~31) + perm32(R & 31)) : R;
        voffA[i] = (unsigned)(R * g.lda + C) * 2u; voffB[i] = (unsigned)(Rb * g.ldb + C) * 2u; }
    const size_t kstep = (size_t)(BK * 2);
    const size_t hstepA = (size_t)HALF * g.lda * 2, hstepB = (size_t)HALF * g.ldb * 2;
    const size_t tstepA = 2 * hstepA, tstepB = 2 * hstepB;
    const unsigned ldsw = (unsigned)wid * 1024u;
    const int aoff = lds_byte(wr * 64 + fr, fq * 8), boff = lds_byte(wc * 32 + fr, fq * 8);
#define PG8_SA(b, h) (((b) * 2 + (h)) * HTB)
#define PG8_SB(b, h) ((4 + (b) * 2 + (h)) * HTB)
#define PG8_STAGE(bufoff, gbase, voff) do { _Pragma("unroll") for (int _i = 0; _i < 2; ++_i) \
        __builtin_amdgcn_global_load_lds((const unsigned*)((const char*)(gbase) + (voff)[_i]), (LAS unsigned*)(lds + (bufoff) + ldsw + _i * 8192), 16, 0, 0); } while (0)
#define PG8_LDA(dst, b, h) do { _Pragma("unroll") for (int m = 0; m < 4; ++m) _Pragma("unroll") for (int k = 0; k < 2; ++k) dst[m][k] = *(const LAS bf16x8*)(lds + PG8_SA(b, h) + aoff + m * 2048 + k * 1024); } while (0)
#define PG8_LDB(dst, b, h) do { _Pragma("unroll") for (int n = 0; n < 2; ++n) _Pragma("unroll") for (int k = 0; k < 2; ++k) dst[n][k] = *(const LAS bf16x8*)(lds + PG8_SB(b, h) + boff + n * 2048 + k * 1024); } while (0)
#define PG8_MMA(ai, bj, At, Bt) do { __builtin_amdgcn_s_setprio(1); _Pragma("unroll") for (int m = 0; m < 4; ++m) _Pragma("unroll") for (int n = 0; n < 2; ++n) _Pragma("unroll") for (int k = 0; k < 2; ++k) \
        acc[ai][bj][m][n] = __builtin_amdgcn_mfma_f32_16x16x32_bf16(Bt[n][k], At[m][k], acc[ai][bj][m][n], 0, 0, 0); __builtin_amdgcn_s_setprio(0); } while (0)
#define PG8_WAIT_V(n) asm volatile("s_waitcnt vmcnt(" #n ")" ::: "memory")
#define PG8_WAIT_L(n) asm volatile("s_waitcnt lgkmcnt(" #n ")" ::: "memory")
#define PG8_BAR __builtin_amdgcn_s_barrier()
#define PG8_SCHED __builtin_amdgcn_sched_barrier(0)
    Unit cur, nxt; int ui = 0;
    if (!S.next(0, cur)) return;
    f32x4 acc[2][2][4][2];
    if constexpr (Epi::ACC_INIT) E.init(acc, cur, wr, wc, fr, fq);
    else {
#pragma unroll
    for (int a = 0; a < 2; ++a)
#pragma unroll
        for (int b = 0; b < 2; ++b)
#pragma unroll
            for (int m = 0; m < 4; ++m)
#pragma unroll
                for (int n = 0; n < 2; ++n) acc[a][b][m][n] = (f32x4){0.f, 0.f, 0.f, 0.f};
    }
    bf16x8 At[4][2], B0[2][2], B1[2][2];
    const char* cA = (const char*)g.A + (size_t)cur.pm * tstepA; const char* cB = (const char*)g.Bt + (size_t)cur.pn * tstepB;
    PG8_STAGE(PG8_SB(0, 0), cB, voffB); PG8_STAGE(PG8_SA(0, 0), cA, voffA); PG8_STAGE(PG8_SB(0, 1), cB + hstepB, voffB); PG8_STAGE(PG8_SA(0, 1), cA + hstepA, voffA);
    if (wr == 1) PG8_BAR;
    PG8_WAIT_V(4); PG8_BAR;
    PG8_STAGE(PG8_SB(1, 0), cB + kstep, voffB); PG8_STAGE(PG8_SA(1, 0), cA + kstep, voffA); PG8_STAGE(PG8_SB(1, 1), cB + hstepB + kstep, voffB);
    PG8_WAIT_V(6); PG8_BAR;
    for (;;) {
        const bool has_next = S.next(ui + 1, nxt);
        const char* nA = has_next ? (const char*)g.A + (size_t)nxt.pm * tstepA : cA; const char* nB = has_next ? (const char*)g.Bt + (size_t)nxt.pn * tstepB : cB;
        for (int t = 0; t < nt; t += 2) {
            const bool last = (t == nt - 2);
            const char* a1 = cA + (size_t)(t + 1) * kstep;
            const char* a2 = last ? nA : cA + (size_t)(t + 2) * kstep; const char* b2 = last ? nB : cB + (size_t)(t + 2) * kstep;
            const char* a3 = a2 + kstep; const char* b3 = b2 + kstep;
            PG8_LDB(B0, 0, 0); PG8_SCHED; PG8_LDA(At, 0, 0); PG8_STAGE(PG8_SA(1, 1), a1 + hstepA, voffA);
            PG8_WAIT_L(8); PG8_BAR; PG8_WAIT_L(0); PG8_MMA(0, 0, At, B0); PG8_BAR; PG8_SCHED;
            PG8_LDB(B1, 0, 1); PG8_STAGE(PG8_SB(0, 0), b2, voffB);
            PG8_BAR; PG8_WAIT_L(0); PG8_MMA(0, 1, At, B1); PG8_BAR;
            PG8_LDA(At, 0, 1); PG8_STAGE(PG8_SA(0, 0), a2, voffA);
            PG8_BAR; PG8_WAIT_L(0); PG8_MMA(1, 0, At, B0); PG8_BAR; PG8_SCHED;
            PG8_STAGE(PG8_SB(0, 1), b2 + hstepB, voffB);
            PG8_WAIT_V(6); PG8_BAR; PG8_MMA(1, 1, At, B1); PG8_BAR;
            PG8_LDB(B0, 1, 0); PG8_SCHED; PG8_LDA(At, 1, 0); PG8_STAGE(PG8_SA(0, 1), a2 + hstepA, voffA);
            PG8_WAIT_L(8); PG8_BAR; PG8_WAIT_L(0); PG8_MMA(0, 0, At, B0); PG8_BAR; PG8_SCHED;
            PG8_LDB(B1, 1, 1); PG8_STAGE(PG8_SB(1, 0), b3, voffB);
            PG8_BAR; PG8_WAIT_L(0); PG8_MMA(0, 1, At, B1); PG8_BAR;
            PG8_LDA(At, 1, 1); PG8_STAGE(PG8_SA(1, 0), a3, voffA);
            PG8_BAR; PG8_WAIT_L(0); PG8_MMA(1, 0, At, B0); PG8_BAR; PG8_SCHED;
            PG8_STAGE(PG8_SB(1, 1), b3 + hstepB, voffB);
            PG8_WAIT_V(6); PG8_BAR; PG8_MMA(1, 1, At, B1); PG8_BAR;
        }
        if constexpr (!Epi::AFTER_DRAIN) E(acc, cur, wr, wc, fr, fq);
        if (!has_next) break;
#pragma unroll
        for (int a = 0; a < 2; ++a)
#pragma unroll
            for (int b = 0; b < 2; ++b)
#pragma unroll
                for (int m = 0; m < 4; ++m)
#pragma unroll
                    for (int n = 0; n < 2; ++n) acc[a][b][m][n] = (f32x4){0.f, 0.f, 0.f, 0.f};
        cur = nxt; cA = nA; cB = nB; ++ui;
    }
    PG8_WAIT_V(0);
    if (wr == 0) PG8_BAR;
    PG8_BAR;
    if constexpr (Epi::AFTER_DRAIN) E.fused(acc, cur, wr, wc, fr, fq, lds, wid, lane);
#undef PG8_SA
#undef PG8_SB
#undef PG8_STAGE
#undef PG8_LDA
#undef PG8_LDB
#undef PG8_MMA
#undef PG8_WAIT_V
#undef PG8_WAIT_L
#undef PG8_BAR
#undef PG8_SCHED
}
}

constexpr int AT_KSTR = 272, AT_VSTR = 288, AT_VOFF = 256 * AT_KSTR;
struct AttnRegs { u32x4 k[8], v[8]; bf16x8 q[4]; };
__device__ __forceinline__ void attn_decode(int u, int& p, int& b, int& h, int& r, int& blk) {
    const int bh = u / 48, w = u % 48; b = bh >> 3; h = bh & 7;
    if (w < 16) { p = 0; r = 0; blk = w; } else if (w < 32) { p = 1; r = (w - 16) >> 2; blk = (w - 16) & 3; } else { p = 2; r = w - 32; blk = 0; }
}
__device__ __forceinline__ void attn_issue(const bf16_t* __restrict__ Z, int u, AttnRegs& R, int tid) {
    int p, b, h, r, nb; attn_decode(u, p, b, h, r, nb);
    const int d = (p == 0) ? 1 : (p == 1 ? 4 : 16), kidx0 = nb * 128 - 128;
    const int wid = tid >> 6, lane = tid & 63, fr = lane & 15, fq = lane >> 4;
#pragma unroll
    for (int i = 0; i < 8; ++i) { const int id = tid + 512 * i, key = id >> 4, ch = id & 15, kidx = kidx0 + key;
        R.k[i] = (u32x4){0u, 0u, 0u, 0u}; R.v[i] = (u32x4){0u, 0u, 0u, 0u};
        if (kidx >= 0) { const bf16_t* rowp = Z + (size_t)(b * SEQ + kidx * d + r) * LDZ0; R.k[i] = *(const u32x4*)(rowp + 1024 + h * 128 + ch * 8); R.v[i] = *(const u32x4*)(rowp + 2048 + h * 128 + ch * 8); } }
    const int qi = wid * 16 + fr, qpos = (nb * 128 + qi) * d + r;
    const bf16_t* qrow = Z + (size_t)(b * SEQ + qpos) * LDZ0 + h * 128;
#pragma unroll
    for (int s = 0; s < 4; ++s) R.q[s] = *(const bf16x8*)(qrow + 32 * s + 8 * fq);
}
__device__ __forceinline__ void attn_unit(const bf16_t* __restrict__ Z, bf16_t* __restrict__ OP, float* __restrict__ LSE, unsigned char* lds, int u, int unext, AttnRegs& R) {
    const int tid = otid(), wid = tid >> 6, lane = tid & 63, fr = lane & 15, fq = lane >> 4;
    int p, b, h, r, nb; attn_decode(u, p, b, h, r, nb);
    const int d = (p == 0) ? 1 : (p == 1 ? 4 : 16);
    const int kidx0 = nb * 128 - 128;
    __syncthreads();
#pragma unroll
    for (int i = 0; i < 8; ++i) { const int id = tid + 512 * i, key = id >> 4, ch = id & 15;
        *(u32x4*)(lds + key * AT_KSTR + ch * 16) = R.k[i]; *(u32x4*)(lds + AT_VOFF + key * AT_VSTR + ch * 16) = R.v[i]; }
    if (tid < 288) *(u32x4*)(lds + AT_VOFF + 256 * AT_VSTR + tid * 16) = (u32x4){0u, 0u, 0u, 0u};
    const int qi = wid * 16 + fr, qpos = (nb * 128 + qi) * d + r;
    bf16x8 qf[4];
#pragma unroll
    for (int s = 0; s < 4; ++s) qf[s] = R.q[s];
    if (unext >= 0) attn_issue(Z, unext, R, tid);
    __syncthreads();
    f32x4 sc[10];
    const int widu = __builtin_amdgcn_readfirstlane(wid);
    const bool firstblk = (nb == 0);
#pragma unroll
    for (int kt = 0; kt < 9; ++kt) { sc[kt] = (f32x4){0.f, 0.f, 0.f, 0.f};
        if (!firstblk || widu + kt >= 8) {
#pragma unroll
        for (int s = 0; s < 4; ++s) { const bf16x8 kf = *(const bf16x8*)(lds + (16 * (wid + kt) + fr) * AT_KSTR + (32 * s + 8 * fq) * 2); sc[kt] = mfma16(kf, qf[s], sc[kt]); } } }
    sc[9] = (f32x4){0.f, 0.f, 0.f, 0.f};
    const float NEG = -__builtin_inff();
    float m = -1e30f;
#pragma unroll
    for (int kt = 0; kt < 9; ++kt) { const bool tile_ok = (nb != 0) || (wid + kt >= 8);
#pragma unroll
        for (int ri = 0; ri < 4; ++ri) { bool valid = tile_ok;
            if (kt == 0) valid = valid && (4 * fq + ri >= fr);
            if (kt == 8) valid = valid && (4 * fq + ri <= fr);
            const float s = valid ? sc[kt][ri] : NEG; sc[kt][ri] = s; m = fmaxf(m, s); } }
    m = fmaxf(m, __shfl_xor(m, 16)); m = fmaxf(m, __shfl_xor(m, 32));
    constexpr float C2 = 0.08838834764831845f * 1.4426950408889634f;
    const float mC = -m * C2;
    float l = 0.f;
#pragma unroll
    for (int kt = 0; kt < 9; ++kt)
#pragma unroll
        for (int ri = 0; ri < 4; ++ri) { const float e = __builtin_amdgcn_exp2f(fmaf(sc[kt][ri], C2, mC)); sc[kt][ri] = e; l += e; }
    l += __shfl_xor(l, 16); l += __shfl_xor(l, 32);
    f32x4 o[8];
#pragma unroll
    for (int et = 0; et < 8; ++et) o[et] = (f32x4){0.f, 0.f, 0.f, 0.f};
    const int q4 = fr >> 2, p4 = fr & 3;
    const unsigned char* vbase = lds + AT_VOFF + (16 * wid + 4 * fq + q4) * AT_VSTR + 8 * p4;
#pragma unroll
    for (int st = 0; st < 5; ++st) {
        if (firstblk && widu + 2 * st + 1 < 8) continue;
        const u32x2 plo = pack4(sc[2 * st]), phi = pack4(sc[2 * st + 1]);
        u32x4 pw = {plo.x, plo.y, phi.x, phi.y}; const bf16x8 pb = *reinterpret_cast<bf16x8*>(&pw);
#pragma unroll
        for (int et = 0; et < 8; ++et) {
            const s16x4 lo = __builtin_amdgcn_ds_read_tr16_b64_v4i16((LAS s16x4*)(vbase + (32 * st) * AT_VSTR + et * 32));
            const s16x4 hi = __builtin_amdgcn_ds_read_tr16_b64_v4i16((LAS s16x4*)(vbase + (32 * st + 16) * AT_VSTR + et * 32));
            const bf16x8 va = {lo[0], lo[1], lo[2], lo[3], hi[0], hi[1], hi[2], hi[3]};
            o[et] = mfma16(va, pb, o[et]); }
    }
    const float inv = 1.0f / l; const size_t token = (size_t)b * SEQ + qpos;
    bf16_t* orow = OP + (size_t)p * NTOK * 1024 + token * 1024 + h * 128 + 4 * fq;
#pragma unroll
    for (int et = 0; et < 8; ++et) *(u32x2*)(orow + 16 * et) = pack4(o[et] * inv);
    if (fq == 0) LSE[((size_t)p * NTOK + token) * 8 + h] = m * 0.08838834764831845f + __logf(l);
}

template <bool HG> __device__ __forceinline__ bf16_t* us_chunk(unsigned char* ws, int c) {
    if (!HG) return (bf16_t*)(ws + WS_HN) + (size_t)c * 256 * 128;
    return (c < 512) ? (bf16_t*)(ws + WS_WT_IN1) + (size_t)c * 128 * 128 : (bf16_t*)(ws + WS_OB) + (size_t)(c - 512) * 128 * 128;
}
constexpr size_t WS_DV = WS_END, WS_EMV = WS_END + 524288, WS_BAR = WS_END + 1048576, WS_CNT = WS_BAR + 16384, WS_XS = WS_BAR + 32768, WS_TOP = WS_XS + 524288;
struct GlrRegs { u32x4 k[2], q[2], v[4], gl, s[8]; float wg[16], bg, g0, g1; };
template <bool HG, bool PC>
__device__ __forceinline__ void glr_issue(const Params& P, int cc, GlrRegs& R, int tid) {
    constexpr int V = HG ? 128 : 256, VCH = V / 8;
    const int bh = cc >> 5, n = cc & 31;
    const int b = HG ? (bh >> 3) : (bh >> 2), h = HG ? (bh & 7) : (bh & 3);
    const bf16_t* Zb = (const bf16_t*)(P.ws + WS_Z); const int ld = HG ? LDZ1 : LDZ0;
    const int qcol = HG ? h * 128 : 3072 + h * 128, kcol = HG ? 1024 + h * 128 : 3584 + h * 128, vcol = HG ? 2048 + h * 128 : 4096 + h * 256;
    const size_t row0 = (size_t)b * SEQ + n * 64;
#pragma unroll
    for (int i = 0; i < 2; ++i) { const int id = tid + 512 * i, t = id >> 4, ch = id & 15; const bf16_t* rowp = Zb + (row0 + t) * ld;
        R.k[i] = *(const u32x4*)(rowp + kcol + ch * 8);
        if (PC) R.q[i] = *(const u32x4*)(rowp + qcol + ch * 8); }
#pragma unroll
    for (int i = 0; i < V / 64; ++i) { const int id = tid + 512 * i, t = id / VCH, ch = id % VCH;
        R.v[i] = *(const u32x4*)(Zb + (row0 + t) * ld + vcol + ch * 8); }
    if (!HG && tid < 128) { const int t = tid >> 1, hf = tid & 1; R.gl = *(const u32x4*)(Zb + (row0 + t) * ld + 7168 + hf * 8); }
    { const int kc = tid & 127;
      if (!HG) {
#pragma unroll
          for (int r = 0; r < 16; ++r) R.wg[r] = P.gla_w_gate[r * 512 + h * 128 + kc];
          R.bg = P.gla_b_gate[h * 128 + kc];
      } else { R.g0 = P.hgrn_gamma[h * 128 + kc]; R.g1 = P.hgrn_gamma[1024 + h * 128 + kc]; } }
    if (PC) { const bf16_t* usp = us_chunk<HG>(P.ws, cc);
#pragma unroll
        for (int i = 0; i < V / 32; ++i) R.s[i] = *(const u32x4*)(usp + (size_t)(tid + 512 * i) * 8); }
}
template <bool HG, bool PC>
__device__ __forceinline__ void glr_chunk(const Params& P, unsigned char* lds, int cc, int cnext, GlrRegs& R) {
    const int bh = cc >> 5, n = cc & 31;
    constexpr int V = HG ? 128 : 256, VSTR = HG ? 288 : 544, VCH = V / 8;
    unsigned char* RK = lds; unsigned char* RQ = lds + 17408; unsigned char* VV = lds + 34816; bf16_t* SC = (bf16_t*)(lds + 69632);
    float* PART = (float*)(lds + 78848); float* EM = (float*)(lds + 80896); float* ELM = EM + 128; unsigned char* GLb = lds + 82432;
    bf16_t* Ks = (bf16_t*)RK; bf16_t* Qs = (bf16_t*)RQ;
    const int tid = otid(), wid = tid >> 6, lane = tid & 63, fr = lane & 15, fq = lane >> 4, q4 = fr >> 2, p4 = fr & 3;
    const int b = HG ? (bh >> 3) : (bh >> 2), h = HG ? (bh & 7) : (bh & 3);
    const bf16_t* Zb = (const bf16_t*)(P.ws + WS_Z); const int ld = HG ? LDZ1 : LDZ0;
    const int qcol = HG ? h * 128 : 3072 + h * 128, kcol = HG ? 1024 + h * 128 : 3584 + h * 128;
    const int vcol = HG ? 2048 + h * 128 : 4096 + h * 256, ocol = HG ? h * 128 : h * 256;
    float* DV = (float*)(P.ws + WS_DV); float* EMV = (float*)(P.ws + WS_EMV);
    const int c = bh * 32 + n;
    bf16_t* USc = us_chunk<HG>(P.ws, c);
    const size_t row0 = (size_t)b * SEQ + n * 64;
    const int kc = tid & 127, tq = tid >> 7;
    __syncthreads();
#pragma unroll
    for (int i = 0; i < 2; ++i) { const int id = tid + 512 * i, t = id >> 4, ch = id & 15;
        *(u32x4*)(RK + t * 272 + ch * 16) = R.k[i];
        if (PC) *(u32x4*)(RQ + t * 272 + ch * 16) = R.q[i]; }
#pragma unroll
    for (int i = 0; i < V / 64; ++i) { const int id = tid + 512 * i, t = id / VCH, ch = id % VCH;
        *(u32x4*)(VV + t * VSTR + ch * 16) = R.v[i]; }
    if (!HG && tid < 128) { const int t = tid >> 1, hf = tid & 1; *(u32x4*)(GLb + t * 32 + hf * 16) = R.gl; }
    unsigned char* SS = lds + 84480;
    if (PC) {
#pragma unroll
        for (int i = 0; i < V / 32; ++i) { const int id = tid + 512 * i; *(u32x4*)(SS + (id >> 4) * 272 + (id & 15) * 16) = R.s[i]; } }
    unsigned wgp[8]; float bgk = 0.f, lbk = 0.f;
    if (!HG) {
#pragma unroll
        for (int r = 0; r < 8; ++r) wgp[r] = cvt_pk_bf16(R.wg[2 * r], R.wg[2 * r + 1]);
        bgk = R.bg;
    } else {
#pragma unroll
        for (int r = 0; r < 8; ++r) wgp[r] = 0u;
        lbk = sigmoidf_(R.g1 - R.g0);
    }
    if (cnext >= 0) glr_issue<HG, PC>(P, cnext, R, tid);
    __syncthreads();
    float qv[16], kv[16], lg[16];
#pragma unroll
    for (int i = 0; i < 16; ++i) { const int t = tq * 16 + i;
        const float kraw = bf2f(Ks[t * 136 + kc]); const float qraw = PC ? bf2f(Qs[t * 136 + kc]) : 0.f;
        if (HG) { const float f = lbk + (1.0f - lbk) * sigmoidf_(kraw); lg[i] = __logf(f); kv[i] = 1.0f - f; qv[i] = siluf_(qraw); }
        else { const u32x4 g0 = *(const u32x4*)(GLb + t * 32), g1 = *(const u32x4*)(GLb + t * 32 + 16);
            float x = bgk;
            x = dot2bf(g0.x, wgp[0], x); x = dot2bf(g0.y, wgp[1], x); x = dot2bf(g0.z, wgp[2], x); x = dot2bf(g0.w, wgp[3], x);
            x = dot2bf(g1.x, wgp[4], x); x = dot2bf(g1.y, wgp[5], x); x = dot2bf(g1.z, wgp[6], x); x = dot2bf(g1.w, wgp[7], x);
            lg[i] = logsigmoidf_(x) * (1.0f / 16.0f); kv[i] = kraw; qv[i] = qraw * 0.08838834764831845f; } }
    float run = 0.f;
#pragma unroll
    for (int i = 0; i < 16; ++i) { run += lg[i]; lg[i] = run; }
    PART[tq * 128 + kc] = run;
    __syncthreads();
    const float p0 = PART[kc], p1 = PART[128 + kc], p2 = PART[256 + kc], p3 = PART[384 + kc];
    const float off = (tq > 0 ? p0 : 0.f) + (tq > 1 ? p1 : 0.f) + (tq > 2 ? p2 : 0.f);
    const float bmid = p0 + p1, blast = bmid + p2 + p3;
#pragma unroll
    for (int i = 0; i < 16; ++i) { const float bt = off + lg[i]; const int t = tq * 16 + i;
        Ks[t * 136 + kc] = f2bf(kv[i] * __expf(bmid - bt));
        if (PC) Qs[t * 136 + kc] = f2bf(qv[i] * __expf(bt - bmid)); }
    if (!PC && tq == 0) { ELM[kc] = __expf(blast - bmid); DV[(size_t)c * 128 + kc] = __expf(blast); EMV[(size_t)c * 128 + kc] = __expf(bmid); }
    __syncthreads();
    if (!PC) {
        const int k0 = 16 * wid;
        const unsigned char* abase = RK + (8 * fq + q4) * 272 + (k0 + 4 * p4) * 2;
        bf16x8 af[2];
#pragma unroll
        for (int s = 0; s < 2; ++s) { const s16x4 lo = __builtin_amdgcn_ds_read_tr16_b64_v4i16((LAS s16x4*)(abase + (32 * s) * 272));
            const s16x4 hi = __builtin_amdgcn_ds_read_tr16_b64_v4i16((LAS s16x4*)(abase + (32 * s + 4) * 272));
            af[s] = (bf16x8){lo[0], lo[1], lo[2], lo[3], hi[0], hi[1], hi[2], hi[3]}; }
        const f32x4 el = *(const f32x4*)(ELM + k0 + 4 * fq);
#pragma unroll
        for (int vt = 0; vt < V / 16; ++vt) { f32x4 a = {0.f, 0.f, 0.f, 0.f};
            const unsigned char* bbase = VV + (8 * fq + q4) * VSTR + (16 * vt + 4 * p4) * 2;
#pragma unroll
            for (int s = 0; s < 2; ++s) { const s16x4 lo = __builtin_amdgcn_ds_read_tr16_b64_v4i16((LAS s16x4*)(bbase + (32 * s) * VSTR));
                const s16x4 hi = __builtin_amdgcn_ds_read_tr16_b64_v4i16((LAS s16x4*)(bbase + (32 * s + 4) * VSTR));
                const bf16x8 bfv = {lo[0], lo[1], lo[2], lo[3], hi[0], hi[1], hi[2], hi[3]}; a = mfma16(af[s], bfv, a); }
            *(u32x2*)(USc + (size_t)(16 * vt + fr) * 128 + k0 + 4 * fq) = pack4(a * el); }
    } else {
        const float* ng = HG ? P.hgrn_norm_g : P.gla_norm_g;
        const size_t trow = row0 + 16 * (wid & 3) + fr; const bf16_t* grow = Zb + trow * ld + (HG ? 4096 : 6144) + ocol;
        u32x2 gwv[V / 32]; f32x4 gnv[V / 32];
#pragma unroll
        for (int i = 0; i < V / 32; ++i) { const int v0 = 16 * ((wid >> 2) + 2 * i) + 4 * fq; gwv[i] = *(const u32x2*)(grow + v0); gnv[i] = *(const f32x4*)(ng + ocol + v0); }
        { const int it = wid & 3;
#pragma unroll
          for (int jj = 0; jj < 2; ++jj) { const int jt = 2 * (wid >> 2) + jj; f32x4 a = {0.f, 0.f, 0.f, 0.f};
#pragma unroll
              for (int s = 0; s < 4; ++s) { const bf16x8 afr = *(const bf16x8*)(Ks + (16 * jt + fr) * 136 + 32 * s + 8 * fq); const bf16x8 bfv = *(const bf16x8*)(Qs + (16 * it + fr) * 136 + 32 * s + 8 * fq); a = mfma16(afr, bfv, a); }
              const int i = 16 * it + fr, j0 = 16 * jt + 4 * fq;
#pragma unroll
              for (int ri = 0; ri < 4; ++ri) a[ri] = (j0 + ri <= i) ? a[ri] : 0.f;
              *(u32x2*)(SC + i * 72 + j0) = pack4(a); } }
        __syncthreads();
        const int tt = wid & 3;
        bf16x8 qb[4], sb[2];
#pragma unroll
        for (int s = 0; s < 4; ++s) qb[s] = *(const bf16x8*)(Qs + (16 * tt + fr) * 136 + 32 * s + 8 * fq);
#pragma unroll
        for (int s = 0; s < 2; ++s) sb[s] = *(const bf16x8*)(SC + (16 * tt + fr) * 72 + 32 * s + 8 * fq);
        f32x4 acc[V / 32]; float ss = 0.f;
#pragma unroll
        for (int i = 0; i < V / 32; ++i) { const int vt = (wid >> 2) + 2 * i; f32x4 a = {0.f, 0.f, 0.f, 0.f};
            const unsigned char* sp = SS + (16 * vt + fr) * 272 + 16 * fq;
#pragma unroll
            for (int s = 0; s < 4; ++s) { const bf16x8 afr = *(const bf16x8*)(sp + 64 * s); a = mfma16(afr, qb[s], a); }
            const unsigned char* vb = VV + (8 * fq + q4) * VSTR + (16 * vt + 4 * p4) * 2;
#pragma unroll
            for (int s = 0; s < 2; ++s) { const s16x4 lo = __builtin_amdgcn_ds_read_tr16_b64_v4i16((LAS s16x4*)(vb + (32 * s) * VSTR));
                const s16x4 hi = __builtin_amdgcn_ds_read_tr16_b64_v4i16((LAS s16x4*)(vb + (32 * s + 4) * VSTR));
                const bf16x8 afr = {lo[0], lo[1], lo[2], lo[3], hi[0], hi[1], hi[2], hi[3]}; a = mfma16(afr, sb[s], a); }
            acc[i] = a; ss += a[0] * a[0] + a[1] * a[1] + a[2] * a[2] + a[3] * a[3]; }
        ss += __shfl_xor(ss, 16); ss += __shfl_xor(ss, 32);
        if (fq == 0) PART[(wid >> 2) * 64 + 16 * tt + fr] = ss;
        __syncthreads();
        const float tot = PART[16 * tt + fr] + PART[64 + 16 * tt + fr];
        const float rinv = rsqrtf(tot * (1.0f / V) + 1e-6f);
        bf16_t* Yb = (bf16_t*)(P.ws + (HG ? WS_HN : WS_OB));
#pragma unroll
        for (int i = 0; i < V / 32; ++i) { const int vt = (wid >> 2) + 2 * i, v0 = 16 * vt + 4 * fq;
            const u32x2 gw = gwv[i]; const f32x4 gn = gnv[i];
            f32x4 y; y[0] = acc[i][0] * rinv * gn[0] * siluf_(lo_bf(gw.x)); y[1] = acc[i][1] * rinv * gn[1] * siluf_(hi_bf(gw.x));
            y[2] = acc[i][2] * rinv * gn[2] * siluf_(lo_bf(gw.y)); y[3] = acc[i][3] * rinv * gn[3] * siluf_(hi_bf(gw.y));
            *(u32x2*)(Yb + trow * DM + 1024 + ocol + v0) = pack4(y); }
    }
}
template <bool HG>
__device__ __forceinline__ void glr_scan(const Params& P, int bid, int nb, int t0 = 0, int nt = 512) {
    constexpr int V = HG ? 128 : 256;
    const float* __restrict__ DV = (const float*)(P.ws + WS_DV); const float* __restrict__ EMV = (const float*)(P.ws + WS_EMV);
    const int tid = otid();
    for (int gid = bid * nt + tid - t0; gid < 131072; gid += nb * nt) {
        const int kq = gid & 31, v = (gid >> 5) % V, bh = gid / (32 * V);
        f32x4 S = {0.f, 0.f, 0.f, 0.f};
        for (int n0 = 0; n0 < 32; n0 += 16) { u32x2 uw[16]; f32x4 d[16], em[16];
#pragma unroll
            for (int j = 0; j < 16; ++j) { const size_t c = (size_t)bh * 32 + n0 + j; uw[j] = *(const u32x2*)(us_chunk<HG>(P.ws, (int)c) + (size_t)v * 128 + 4 * kq);
                d[j] = *(const f32x4*)(DV + c * 128 + 4 * kq); em[j] = *(const f32x4*)(EMV + c * 128 + 4 * kq); }
#pragma unroll
            for (int j = 0; j < 16; ++j) { const size_t c = (size_t)bh * 32 + n0 + j;
                *(u32x2*)(us_chunk<HG>(P.ws, (int)c) + (size_t)v * 128 + 4 * kq) = pack4(S * em[j]);
                const f32x4 u = {lo_bf(uw[j].x), hi_bf(uw[j].x), lo_bf(uw[j].y), hi_bf(uw[j].y)};
                S = S * d[j] + u; } }
    }
}

__device__ __forceinline__ void gate_l0(const Params& P, int bid, int nb, int w0 = 0, int nw = 8) {
    const int tid_ = otid(); const int wid = (tid_ >> 6) - w0, lane = tid_ & 63;
    const bf16_t* __restrict__ OP = (const bf16_t*)P.out; const float* __restrict__ LSE = (const float*)((const unsigned char*)P.out + DO_LSE);
    const bf16_t* __restrict__ Z = (const bf16_t*)(P.ws + WS_Z); bf16_t* __restrict__ Y = (bf16_t*)(P.ws + WS_OB);
#pragma unroll 2
    for (int token = bid * nw + wid; token < NTOK; token += nb * nw) {
        {
            const int c0 = lane * 16, head = lane >> 3;
            const float l0 = LSE[((size_t)0 * NTOK + token) * 8 + head], l1 = LSE[((size_t)1 * NTOK + token) * 8 + head], l2 = LSE[((size_t)2 * NTOK + token) * 8 + head];
            const float mx = fmaxf(l0, fmaxf(l1, l2)); float w0 = __expf(l0 - mx), w1 = __expf(l1 - mx), w2 = __expf(l2 - mx); const float ws = 1.0f / (w0 + w1 + w2); w0 *= ws; w1 *= ws; w2 *= ws;
#pragma unroll
            for (int hf = 0; hf < 2; ++hf) { const int c = c0 + hf * 8;
                const u32x4 a = *(const u32x4*)(OP + (size_t)token * 1024 + c), bq = *(const u32x4*)(OP + ((size_t)NTOK + token) * 1024 + c), cq = *(const u32x4*)(OP + ((size_t)2 * NTOK + token) * 1024 + c);
                const u32x4 gv = *(const u32x4*)(Z + (size_t)token * LDZ0 + 5120 + c);
                const unsigned aw[4] = {a.x, a.y, a.z, a.w}, bw[4] = {bq.x, bq.y, bq.z, bq.w}, cw[4] = {cq.x, cq.y, cq.z, cq.w}, gw[4] = {gv.x, gv.y, gv.z, gv.w};
                unsigned ow[4];
#pragma unroll
                for (int i = 0; i < 4; ++i) { const float ylo = (w0 * lo_bf(aw[i]) + w1 * lo_bf(bw[i]) + w2 * lo_bf(cw[i])) * siluf_(lo_bf(gw[i])); const float yhi = (w0 * hi_bf(aw[i]) + w1 * hi_bf(bw[i]) + w2 * hi_bf(cw[i])) * siluf_(hi_bf(gw[i])); ow[i] = cvt_pk_bf16(ylo, yhi); }
                *(u32x4*)(Y + (size_t)token * DM + c) = (u32x4){ow[0], ow[1], ow[2], ow[3]}; }
        }
    }
}
__device__ __forceinline__ void s5_disc(const Params& P, int g, int p, float& lr, float& li, float& dt, float& cor, float& coi) {
    lr = P.lam_re[g * 64 + p]; li = P.lam_im[g * 64 + p]; dt = __expf(P.log_dt[g]);
    const float mag = __expf(lr * dt), ang = li * dt; const float ar = mag * __cosf(ang), ai = mag * __sinf(ang);
    const float inv = 1.0f / (lr * lr + li * li); const float nr = ar - 1.0f, ni = ai;
    cor = (nr * lr + ni * li) * inv; coi = (ni * lr - nr * li) * inv;
}
__device__ __forceinline__ void s5_gen(const Params& P, unsigned char* lds, int bid, int nb) {
    float* AP = (float*)lds;
    float* CC = AP + 384;
    float* BB = CC + 2048;
    float* KT = BB + 2048;
    bf16_t* E = (bf16_t*)(P.ws + WS_S5B1); bf16_t* TF = (bf16_t*)(P.ws + WS_S5B2);
    const int tid = otid();
    for (int item = bid; item < 256; item += nb) {
        const int g = item >> 2;
        __syncthreads();
#pragma unroll
        for (int rep = 0; rep < 2; ++rep) { const int idx = tid + rep * 512;
            { const int p = idx >> 4, hp = idx & 15; float lr, li, dt, cr, ci; s5_disc(P, g, p, lr, li, dt, cr, ci);
              const float br = P.b_re[(g * 64 + p) * 16 + hp], bi = P.b_im[(g * 64 + p) * 16 + hp];
              BB[idx * 2] = cr * br - ci * bi; BB[idx * 2 + 1] = cr * bi + ci * br; }
            { const int hh = idx >> 6, p = idx & 63; CC[idx * 2] = P.c_re[(g * 16 + hh) * 64 + p]; CC[idx * 2 + 1] = P.c_im[(g * 16 + hh) * 64 + p]; } }
        float lrp = 0.f, lip = 0.f, dtp = 0.f;
        if (tid < 64) { float cr, ci; s5_disc(P, g, tid, lrp, lip, dtp, cr, ci); }
        for (int tt = 0; tt < 4; ++tt) { const int tau = (item & 3) * 4 + tt;
        if (tid < 64) { const int e3[3] = {tau, tau + 1, 15 - tau};
#pragma unroll
            for (int q = 0; q < 3; ++q) { const float mg = __expf(lrp * dtp * (float)e3[q]), an = lip * dtp * (float)e3[q]; AP[(q * 64 + tid) * 2] = mg * __cosf(an); AP[(q * 64 + tid) * 2 + 1] = mg * __sinf(an); } }
        __syncthreads();
        if (tid < 256) { const int hh = tid >> 4, hp = tid & 15; float s = 0.f;
            for (int p = 0; p < 64; ++p) { const float cr = CC[(hh * 64 + p) * 2], ci = CC[(hh * 64 + p) * 2 + 1], ar = AP[p * 2], ai = AP[p * 2 + 1];
                const float t1r = cr * ar - ci * ai, t1i = cr * ai + ci * ar; s += t1r * BB[(p * 16 + hp) * 2] - t1i * BB[(p * 16 + hp) * 2 + 1]; }
            if (tau == 0 && hh == hp) s += P.s5_d[g * 16 + hh];
            KT[tid] = s;
        } else { const int u = tid - 256;
            {
                const int hh = u >> 4, pg = u & 15; float vals[8];
#pragma unroll
                for (int q = 0; q < 4; ++q) { const int p = pg * 4 + q; const float cr = CC[(hh * 64 + p) * 2], ci = CC[(hh * 64 + p) * 2 + 1], ar = AP[(64 + p) * 2], ai = AP[(64 + p) * 2 + 1];
                    vals[2 * q] = cr * ar - ci * ai; vals[2 * q + 1] = -(cr * ai + ci * ar); }
                u32x4 w; w.x = cvt_pk_bf16(vals[0], vals[1]); w.y = cvt_pk_bf16(vals[2], vals[3]); w.z = cvt_pk_bf16(vals[4], vals[5]); w.w = cvt_pk_bf16(vals[6], vals[7]);
                *(u32x4*)(TF + (size_t)(g * 256 + tau * 16 + hh) * 384 + 256 + pg * 8) = w; }
            {
                const int row = u >> 1, hf = u & 1, p = row >> 1, c = row & 1; const float ar = AP[(128 + p) * 2], ai = AP[(128 + p) * 2 + 1]; float vals[8];
#pragma unroll
                for (int q = 0; q < 8; ++q) { const float br = BB[(p * 16 + hf * 8 + q) * 2], bi = BB[(p * 16 + hf * 8 + q) * 2 + 1]; vals[q] = c ? (ar * bi + ai * br) : (ar * br - ai * bi); }
                u32x4 w; w.x = cvt_pk_bf16(vals[0], vals[1]); w.y = cvt_pk_bf16(vals[2], vals[3]); w.z = cvt_pk_bf16(vals[4], vals[5]); w.w = cvt_pk_bf16(vals[6], vals[7]);
                *(u32x4*)(E + (size_t)(g * 256 + row) * 256 + tau * 16 + hf * 8) = w;
                *(u32x4*)(E + (size_t)(g * 256 + 128 + row) * 256 + tau * 16 + hf * 8) = (u32x4){0u, 0u, 0u, 0u}; }
        }
        __syncthreads();
        const int nblk = (16 - tau) * (tau > 0 ? 2 : 1);
        for (int j = tid; j < nblk * 32; j += 512) { const int blk = j >> 5, rh = j & 31, hrow = rh >> 1, hf = rh & 1;
            const int which = tau > 0 ? (blk & 1) : 0, bi = tau > 0 ? (blk >> 1) : blk;
            u32x4 w = {0u, 0u, 0u, 0u}; int row, col;
            if (which == 0) { row = (bi + tau) * 16 + hrow; col = bi * 16 + hf * 8; const float* kr = KT + hrow * 16 + hf * 8;
                w.x = cvt_pk_bf16(kr[0], kr[1]); w.y = cvt_pk_bf16(kr[2], kr[3]); w.z = cvt_pk_bf16(kr[4], kr[5]); w.w = cvt_pk_bf16(kr[6], kr[7]); }
            else { row = bi * 16 + hrow; col = (bi + tau) * 16 + hf * 8; }
            *(u32x4*)(TF + (size_t)(g * 256 + row) * 384 + col) = w; }
        __syncthreads();
        }
    }
}
__device__ __forceinline__ void s5_scan(const Params& P, int bid, int nb) {
    const int tid = otid(); if (tid < 64) {
    const float* __restrict__ XL = (const float*)(P.ws + WS_XLOC); bf16_t* __restrict__ S5Ap = (bf16_t*)(P.ws + WS_S5A);
    for (int gid = bid * 64 + tid; gid < 16384; gid += nb * 64) {
        const int p = gid & 63, g = (gid >> 6) & 63, b = gid >> 12;
        const float lr = P.lam_re[g * 64 + p], li = P.lam_im[g * 64 + p], dt = __expf(P.log_dt[g]);
        const float mg = __expf(16.0f * lr * dt), an = 16.0f * li * dt; const float ar = mg * __cosf(an), ai = mg * __sinf(an);
        float xr = 0.f, xi = 0.f; const size_t rowb = (size_t)g * 512 + b * 128;
        for (int n0 = 0; n0 < 128; n0 += 32) { f32x2 loc[32];
#pragma unroll
            for (int j = 0; j < 32; ++j) loc[j] = *(const f32x2*)(XL + (rowb + n0 + j) * 128 + 2 * p);
#pragma unroll
            for (int j = 0; j < 32; ++j) { *(unsigned*)(S5Ap + (rowb + n0 + j) * 384 + 256 + 2 * p) = cvt_pk_bf16(xr, xi);
                const float nr = ar * xr - ai * xi + loc[j].x, ni = ar * xi + ai * xr + loc[j].y; xr = nr; xi = ni; } }
    }
    }
}

#define XB_TMO      128
#define XB_XCNT(j)  (256  + 64 * (j))
#define XB_XSUB(j)  (1280 + 64 * (j))
#define XB_XGEN(j)  (2304 + 64 * (j))
#define XB_TOP      3328
#define XB_TOPGEN   3392
#define XCD_BAR_WORDS 3456
#define XB_SPIN_CAP (1u << 18)
__device__ __forceinline__ unsigned xb_ld(unsigned* p)              { return __hip_atomic_load(p, __ATOMIC_RELAXED, __HIP_MEMORY_SCOPE_AGENT); }
__device__ __forceinline__ unsigned xb_add(unsigned* p, unsigned v) { return __hip_atomic_fetch_add(p, v, __ATOMIC_RELAXED, __HIP_MEMORY_SCOPE_AGENT); }
__device__ __forceinline__ unsigned xb_xcc_id() { return (unsigned)__builtin_amdgcn_s_getreg((3 << 11) | 20) & 0xFu; }
#define XB_SPIN(cond, bar) do { unsigned _sp = 0; while (cond) { __builtin_amdgcn_s_sleep(1); \
    if ((++_sp & 255u) == 0u) { if (xb_ld(&(bar)[XB_TMO])) break; if (_sp > XB_SPIN_CAP) { atomicAdd(&(bar)[XB_TMO], 1u); break; } } } } while (0)
__device__ __forceinline__ void xcd_barrier_complete(unsigned* bar, unsigned x, unsigned& nloc, unsigned& nx) {
    const unsigned G = gridDim.x * gridDim.y * gridDim.z;
    unsigned sum, cnt, mine, sp = 0u;
    for (;;) {
        sum = 0u; cnt = 0u; mine = 0u;
#pragma unroll
        for (unsigned j = 0; j < 16; ++j) { const unsigned c = xb_ld(&bar[XB_XCNT(j)]); sum += c; cnt += (c > 0u) ? 1u : 0u; mine = (j == x) ? c : mine; }
        if (sum == G) break;
        __builtin_amdgcn_s_sleep(1);
        if ((++sp & 255u) == 0u) { if (xb_ld(&bar[XB_TMO])) break; if (sp > XB_SPIN_CAP) { atomicAdd(&bar[XB_TMO], 1u); break; } }
    }
    nloc = mine > 0u ? mine : 1u; nx = cnt > 0u ? cnt : 1u;
}
__device__ __forceinline__ void xcd_barrier(unsigned* bar, volatile LAS unsigned* st) {
    asm volatile("s_waitcnt vmcnt(0)" ::: "memory");
    __syncthreads();
    if (threadIdx.x == 0) {
        const unsigned x = xb_xcc_id();
        __builtin_amdgcn_s_waitcnt(0);
        unsigned nloc = st[0], nx = st[1];
        if (nloc == 0u) { xcd_barrier_complete(bar, x, nloc, nx); st[0] = nloc; st[1] = nx; }
        const unsigned old = xb_add(&bar[XB_XSUB(x)], 1u);
        const unsigned gen = old / nloc;
        if (old + 1u == (gen + 1u) * nloc) {
            __builtin_amdgcn_fence(__ATOMIC_RELEASE, "agent");
            asm volatile("s_waitcnt vmcnt(0)" ::: "memory");
            const unsigned og = xb_add(&bar[XB_TOP], 1u);
            const unsigned tg = og / nx;
            if (og + 1u == (tg + 1u) * nx) xb_add(&bar[XB_TOPGEN], 1u);
            else XB_SPIN(xb_ld(&bar[XB_TOPGEN]) == tg, bar);
            __builtin_amdgcn_fence(__ATOMIC_ACQUIRE, "agent");
            xb_add(&bar[XB_XGEN(x)], 1u);
            asm volatile("s_waitcnt vmcnt(0)" ::: "memory");
        } else {
            XB_SPIN(xb_ld(&bar[XB_XGEN(x)]) == gen, bar);
            __builtin_amdgcn_fence(__ATOMIC_ACQUIRE, "agent");
            asm volatile("s_waitcnt vmcnt(0)" ::: "memory");
        }
    }
    __syncthreads();
}

__global__ void __launch_bounds__(512, 2) fwd_megakernel(Params Pk) {
    extern __shared__ __attribute__((aligned(16))) unsigned char lds[];
    LAS unsigned char* glds = (LAS unsigned char*)lds;
    const int ph_lo = Pk.ph_lo, ph_hi = Pk.ph_hi;
    if (threadIdx.x == 0) { volatile LAS unsigned* st0 = (volatile LAS unsigned*)(glds + 155648); st0[0] = 0u; st0[1] = 0u;
        if (ph_hi - ph_lo > 1) (void)xb_add(&((unsigned*)(Pk.ws + WS_BAR))[XB_XCNT(xb_xcc_id())], 1u); }
    __syncthreads();
    if (ph_hi - ph_lo > 1 && blockIdx.x < 64) {
        const char* pc = (const char*)(__builtin_amdgcn_s_getpc() & ~63ull); unsigned accw = 0;
        for (int off = (int)threadIdx.x * 16; off < 208 * 1024; off += 512 * 16) { const u32x4 v = *(const u32x4*)(pc + off); accw += v.x ^ v.y ^ v.z ^ v.w; }
        asm volatile("" :: "v"(accw));
    }
#define WT_IN0 ((bf16_t*)(P.ws + WS_WT_IN0))
#define WT_OUT0 ((bf16_t*)(P.ws + WS_WT_OUT0))
#define WT_IN1 ((bf16_t*)(P.ws + WS_WT_IN1))
#define WT_GLU ((bf16_t*)(P.ws + WS_WT_GLU))
#define WT_OUT1 ((bf16_t*)(P.ws + WS_WT_OUT1))
#define HN ((bf16_t*)(P.ws + WS_HN))
#define Z ((bf16_t*)(P.ws + WS_Z))
#define YC ((bf16_t*)(P.ws + WS_YC))
#define S5A ((bf16_t*)(P.ws + WS_S5A))
#define S5B1 ((bf16_t*)(P.ws + WS_S5B1))
#define S5B2 ((bf16_t*)(P.ws + WS_S5B2))
#define XLOC ((float*)(P.ws + WS_XLOC))
#if defined(__HIP_DEVICE_COMPILE__)
#define PH_LOADP() Params P; { const __attribute__((address_space(4))) unsigned long long* s_ = (const __attribute__((address_space(4))) unsigned long long*)__builtin_amdgcn_kernarg_segment_ptr(); \
        asm volatile("" : "+s"(s_)); unsigned long long* dq_ = (unsigned long long*)&P; _Pragma("unroll") for (int i_ = 0; i_ < (int)(sizeof(Params) / 8); ++i_) dq_[i_] = s_[i_]; }
#else
#define PH_LOADP() const Params P = Pk;
#endif
#define PH_BEGIN(n) if (ph_lo <= (n) && (n) < ph_hi) for (int rep_ = 0; rep_ < ((((DBG_REP) >> (n)) & 1) ? 2 : 1); ++rep_) { \
        if ((n) > ph_lo || rep_) { if (ph_hi > 1000) cg::this_grid().sync(); else xcd_barrier((unsigned*)(Pk.ws + WS_BAR), (volatile LAS unsigned*)(glds + 155648)); } __syncthreads(); \
        int bid = blockIdx.x, nb = gridDim.x; asm volatile("" : "+s"(bid), "+s"(nb)); PH_LOADP()
#define PH_END }
    PH_BEGIN(0)
        rmsnorm_rows<true, 4>(P.x, P.norm_g, HN, bid, nb);
        convert_wt(P.ab_w_in, 2048, 7184, WT_IN0, 7424, 1, (float*)lds, bid, nb);
    PH_END
    PH_BEGIN(1)
        { pg8::StaticOrder S; S.init(NTOK, LDZ0, nb, bid); pg8::EpiZ0 E{Z};
          pg8::gemm_phase(glds, pg8::Gemm{HN, WT_IN0, 2048, 2048, 2048}, S, E); }
        { const int cb = nb == 256 ? bid - 160 : bid, cn = nb == 256 ? 96 : nb;
          if (cb >= 0) { __syncthreads();
            convert_wt(P.ab_w_out, 2048, 2048, WT_OUT0, 2048, 0, (float*)lds, cb, cn);
            convert_wt(P.cd_w_in, 2048, 6144, WT_IN1, 6144, 0, (float*)lds, cb, cn);
            convert_wt(P.w_glu, 1024, 1024, WT_GLU, 1024, 0, (float*)lds, cb, cn); } }
    PH_END
    PH_BEGIN(2)
        if (nb == 256) {
            const int xcd = bid & 7, slot = bid >> 3;
#define ATT_U(j) ((xcd + 8 * ((j) / 48)) * 48 + (j) % 48)
            AttnRegs R; attn_issue(Z, ATT_U(slot), R, otid());
            for (int j = slot; j < 192; j += 32) attn_unit(Z, (bf16_t*)P.out, (float*)((unsigned char*)P.out + DO_LSE), lds, ATT_U(j), (j + 32 < 192) ? ATT_U(j + 32) : -1, R);
#undef ATT_U
        } else { AttnRegs R; if (bid < 1536) attn_issue(Z, bid, R, otid());
          for (int u = bid; u < 1536; u += nb) attn_unit(Z, (bf16_t*)P.out, (float*)((unsigned char*)P.out + DO_LSE), lds, u, (u + nb < 1536) ? u + nb : -1, R); }
        { GlrRegs G; if (bid < 512) glr_issue<false, false>(P, bid, G, otid());
          for (int c = bid; c < 512; c += nb) glr_chunk<false, false>(P, lds, c, (c + nb < 512) ? c + nb : -1, G); }
    PH_END
    PH_BEGIN(3)
        if (otid() < 256) glr_scan<false>(P, bid, nb, 0, 256);
        else gate_l0(P, bid, nb, 4, 4);
        s5_gen(P, lds, bid, nb);
    PH_END
    PH_BEGIN(4)
        { GlrRegs G; if (bid < 512) glr_issue<false, true>(P, bid, G, otid());
          for (int c = bid; c < 512; c += nb) glr_chunk<false, true>(P, lds, c, (c + nb < 512) ? c + nb : -1, G); }
    PH_END
    PH_BEGIN(6)
        pg8::StaticOrder S; S.init(NTOK, DM, nb, bid);
        if (nb == 256) { pg8::EpiNorm<false> E{P.x, P.out, HN, P.norm_g + DM, (float*)(P.ws + WS_XS), (unsigned*)(P.ws + WS_CNT)};
            pg8::gemm_phase(glds, pg8::Gemm{(const bf16_t*)(P.ws + WS_OB), WT_OUT0, 2048, 2048, 2048}, S, E); }
        else { pg8::EpiRes E{P.x, P.out};
            pg8::gemm_phase(glds, pg8::Gemm{(const bf16_t*)(P.ws + WS_OB), WT_OUT0, 2048, 2048, 2048}, S, E); }
    PH_END
    if (gridDim.x != 256) {
    PH_BEGIN(7)
        rmsnorm_rows<true>(P.out, P.norm_g + DM, HN, bid, nb);
    PH_END
    }
    PH_BEGIN(8)
        pg8::StaticOrder S; S.init(NTOK, 6144, nb, bid); pg8::EpiZ1 E{Z, S5A};
        pg8::gemm_phase(glds, pg8::Gemm{HN, WT_IN1, 2048, 2048, 2048}, S, E);
    PH_END
    PH_BEGIN(9)
        { pg8::DiagOrder S{128, nb, bid}; pg8::EpiXloc E{XLOC};
          pg8::gemm_phase(glds, pg8::Gemm{S5A, S5B1, 384, 256, 256}, S, E); }
        { GlrRegs G; if (bid < 1024) glr_issue<true, false>(P, bid, G, otid());
          for (int c = bid; c < 1024; c += nb) glr_chunk<true, false>(P, lds, c, (c + nb < 1024) ? c + nb : -1, G); }
        __syncthreads();
        convert_wt(P.cd_w_out, 2048, 2048, WT_OUT1, 2048, 0, (float*)lds, bid, nb);
    PH_END
    PH_BEGIN(10)
        if (otid() < 64) s5_scan(P, bid, nb);
        else glr_scan<true>(P, bid, nb, 64, 448);
    PH_END
    PH_BEGIN(11)
        { pg8::DiagOrder S{128, nb, bid}; pg8::EpiS2 E{YC};
          pg8::gemm_phase(glds, pg8::Gemm{S5A, S5B2, 384, 384, 384}, S, E); }
        if (nb == 256) { const int c0 = bid < 128 ? bid : 128 + 2 * (bid - 128), cn = bid < 128 ? 1 : 2;
            GlrRegs G; glr_issue<true, true>(P, c0, G, otid());
            for (int c = c0; c < c0 + cn; ++c) glr_chunk<true, true>(P, lds, c, (c + 1 < c0 + cn) ? c + 1 : -1, G); }
        else { GlrRegs G; if (bid < 1024) glr_issue<true, true>(P, bid, G, otid());
            for (int c = bid; c < 1024; c += nb) glr_chunk<true, true>(P, lds, c, (c + nb < 1024) ? c + nb : -1, G); }
    PH_END
    PH_BEGIN(12)
        if (nb != 256 || bid < 128) { pg8::StaticOrder S; S.init(NTOK, 1024, nb == 256 ? 128 : nb, bid); pg8::EpiGlu E{YC, Z, P.b_glu, HN};
            pg8::gemm_phase(glds, pg8::Gemm{YC, WT_GLU, 1024, 1024, 1024}, S, E); }
        else { const int c0 = 384 + 5 * (bid - 128);
            GlrRegs G; glr_issue<true, true>(P, c0, G, otid());
            for (int c = c0; c < c0 + 5; ++c) glr_chunk<true, true>(P, lds, c, (c + 1 < c0 + 5) ? c + 1 : -1, G); }
    PH_END
    PH_BEGIN(13)
        pg8::StaticOrder S; S.init(NTOK, DM, nb, bid);
        if (nb == 256) { pg8::EpiNorm<true> E{P.out, P.out, nullptr, P.final_g, (float*)(P.ws + WS_XS + 262144), (unsigned*)(P.ws + WS_CNT + 8192)};
            pg8::gemm_phase(glds, pg8::Gemm{HN, WT_OUT1, 2048, 2048, 2048}, S, E); }
        else { pg8::EpiRes E{P.out, P.out};
            pg8::gemm_phase(glds, pg8::Gemm{HN, WT_OUT1, 2048, 2048, 2048}, S, E); }
    PH_END
    if (gridDim.x != 256) {
    PH_BEGIN(14)
        rmsnorm_rows<false>(P.out, P.final_g, P.out, bid, nb);
    PH_END
    }
}

extern "C" void kernel_launch(void* const* d_in, const int* in_sizes, int n_in, void* d_out, int out_size, void* d_ws, size_t ws_size, hipStream_t stream) {
    static int grid = 0;
    if (grid == 0) {
        if (n_in != 22 || out_size != NTOK * DM || ws_size < WS_TOP) { fprintf(stderr, "kernel_launch: unexpected shapes n_in %d out %d ws %zu\n", n_in, out_size, ws_size); grid = -1; return; }
        int dev = 0, cus = 0, per_cu = 0;
        (void)hipGetDevice(&dev); (void)hipDeviceGetAttribute(&cus, hipDeviceAttributeMultiprocessorCount, dev);
        if (hipFuncSetAttribute((const void*)fwd_megakernel, hipFuncAttributeMaxDynamicSharedMemorySize, LDS_BYTES) != hipSuccess) { fprintf(stderr, "kernel_launch: hipFuncSetAttribute failed\n"); grid = -1; return; }
        if (hipOccupancyMaxActiveBlocksPerMultiprocessor(&per_cu, (const void*)fwd_megakernel, 512, LDS_BYTES) != hipSuccess || per_cu < 1) { fprintf(stderr, "kernel_launch: occupancy query says %d\n", per_cu); per_cu = 1; }
        (void)hipGetLastError();
        if (cus <= 0) cus = 256;
        grid = cus;
    }
    if (grid < 0) return;
    Params p{};
    const float** pf = (const float**)&p;
    for (int i = 0; i < 22; ++i) pf[i] = (const float*)d_in[i];
    p.out = (float*)d_out; p.ws = (unsigned char*)d_ws;
#if N_LAUNCH_MODE == 1
    (void)hipMemsetAsync((unsigned char*)d_ws + WS_BAR, 0, 32768, stream);
    p.ph_lo = 0; p.ph_hi = NPHASE;
    void* args[] = {&p};
    hipError_t e = hipLaunchCooperativeKernel((const void*)fwd_megakernel, dim3(grid), dim3(512), args, LDS_BYTES, stream);
    if (e != hipSuccess) fprintf(stderr, "cooperative launch failed: %s (grid %d)\n", hipGetErrorString(e), grid);
#else
    for (int ph = 0; ph < NPHASE; ++ph) { p.ph_lo = ph; p.ph_hi = ph + 1; hipLaunchKernelGGL(fwd_megakernel, dim3(grid), dim3(512), LDS_BYTES, stream, p); }
#endif
}
```
